# Optimizing an MI355X kernel written in HIP

```python
import math
import jax, jax.numpy as jnp
from jax import lax
import numpy as np

D_MODEL = 1024
BATCH = 8
SEQ = 4096
DEPTH = 4

HEAD_DIM = 64
D_MIX = D_MODEL
RWKV_HEADS = (3 * D_MIX) // (8 * HEAD_DIM)
D_RWKV = RWKV_HEADS * HEAD_DIM
ATTN_HEADS = (3 * D_MIX) // (8 * HEAD_DIM)
D_ATTN = ATTN_HEADS * HEAD_DIM
D_CONV = D_MIX - D_RWKV - D_ATTN
DECAY_LORA = 32
ICLR_LORA = 32
GATE_LORA = 64
CONV_WIDTH = 31
DILATED_PATTERNS = ((128, 1), (512, 4), (2048, 16))
ATTN_BLOCK = 128
D_FF = 2816
NORM_EPS = 1e-6
RWKV_GN_EPS = 64e-5
CONV_LN_EPS = 1e-5
D_SHIFT = 3 * D_RWKV + DECAY_LORA + ICLR_LORA + GATE_LORA
D_IN = D_SHIFT + 3 * D_ATTN + 2 * D_CONV

kernel_name = 'hybrid_rwkv7_dilattn_conformer_macaron'


def _alibi_slopes(n):
    def pow2(m):
        start = 2.0 ** (-8.0 / m)
        return [start ** (i + 1) for i in range(m)]
    if math.log2(n).is_integer():
        return pow2(n)
    c = 2 ** int(math.floor(math.log2(n)))
    return pow2(c) + pow2(2 * c)[0::2][: n - c]


def _rms_norm(x, g):
    xf = x.astype(jnp.float32)
    y = xf * lax.rsqrt(jnp.mean(xf * xf, axis=-1, keepdims=True) + NORM_EPS)
    return y.astype(x.dtype) * g


def _head_rms(t, g):
    return t * lax.rsqrt(jnp.mean(t * t, axis=-1, keepdims=True) + NORM_EPS) * g.astype(jnp.float32)


def _swiglu(x, w_gate, w_up, w_down):
    return (jax.nn.silu(x @ w_gate) * (x @ w_up)) @ w_down


def _token_shift(p, mu):
    prev = jnp.pad(p, ((0, 0), (1, 0), (0, 0)))[:, :-1]
    return p + (prev - p) * mu.astype(p.dtype)


def _rwkv7_scan(r, w, k, v, kk, a):
    B, S, H, N = r.shape
    xs = tuple(jnp.moveaxis(t, 1, 0) for t in (r, w, k, v, -kk, kk * a))

    def step(state, inp):
        r_t, w_t, k_t, v_t, a_t, b_t = inp
        sa = jnp.einsum('bhij,bhj->bhi', state, a_t)
        state = (state * w_t[:, :, None, :]
                 + sa[..., None] * b_t[:, :, None, :]
                 + v_t[..., None] * k_t[:, :, None, :])
        y_t = jnp.einsum('bhij,bhj->bhi', state, r_t)
        return state, y_t

    state0 = jnp.zeros((B, H, N, N), jnp.float32)
    _, y = lax.scan(step, state0, xs)
    return jnp.moveaxis(y, 0, 1)


def _rwkv7_mixer(p, w0, w2, a0, a2, g2, k_k, k_a, r_k, ln_w, ln_b):
    B, S, _ = p.shape
    o = 0
    r = p[..., o:o + D_RWKV]; o += D_RWKV
    k = p[..., o:o + D_RWKV]; o += D_RWKV
    v = p[..., o:o + D_RWKV]; o += D_RWKV
    xw = p[..., o:o + DECAY_LORA]; o += DECAY_LORA
    xa = p[..., o:o + ICLR_LORA]; o += ICLR_LORA
    xg = p[..., o:o + GATE_LORA]
    f32 = jnp.float32
    w_log = -jax.nn.softplus(-(w0.astype(f32) + jnp.tanh(xw) @ w2.astype(f32))) - 0.5
    decay = jnp.exp(-jnp.exp(w_log))
    a = jax.nn.sigmoid(a0.astype(f32) + xa @ a2.astype(f32))
    g = jax.nn.sigmoid(xg) @ g2.astype(f32)
    heads = lambda t: t.reshape(B, S, RWKV_HEADS, HEAD_DIM)
    kk = heads(k * k_k.astype(f32))
    kk = kk * lax.rsqrt(jnp.sum(kk * kk, axis=-1, keepdims=True) + 1e-12)
    k = k * (1.0 + (a - 1.0) * k_a.astype(f32))
    rh, kh, vh = heads(r), heads(k), heads(v)
    y = _rwkv7_scan(rh, heads(decay), kh, vh, kk, heads(a))
    mu = jnp.mean(y, axis=-1, keepdims=True)
    var = jnp.mean(jnp.square(y - mu), axis=-1, keepdims=True)
    y = ((y - mu) * lax.rsqrt(var + RWKV_GN_EPS)).reshape(B, S, D_RWKV)
    y = y * ln_w.astype(f32) + ln_b.astype(f32)
    bonus = jnp.sum(rh * kh * r_k.astype(f32), axis=-1, keepdims=True) * vh
    return (y + bonus.reshape(B, S, D_RWKV)) * g


def _dilated_attention(q, k, v, slopes, window, dilation):
    B, S, H, N = q.shape
    n_keys = window // dilation
    L = S // dilation
    nb = -(-L // ATTN_BLOCK)
    Lp = nb * ATTN_BLOCK

    def blocks(t):
        t = t.reshape(B, L, dilation, H, N)
        t = jnp.pad(t, ((0, 0), (0, Lp - L), (0, 0), (0, 0), (0, 0)))
        return t.reshape(B, nb, ATTN_BLOCK, dilation, H, N)

    def band(t):
        prev = jnp.pad(t, ((0, 0), (1, 0), (0, 0), (0, 0), (0, 0), (0, 0)))[:, :-1]
        return jnp.concatenate([prev, t], axis=2)

    qb = blocks(q)
    kb = band(blocks(k))
    vb = band(blocks(v))
    s = jnp.einsum('bnqchd,bnkchd->bnqchk', qb, kb)
    qi = jnp.arange(ATTN_BLOCK)
    ki = jnp.arange(2 * ATTN_BLOCK)
    dist = qi[:, None] + ATTN_BLOCK - ki[None, :]
    key_idx = jnp.arange(nb)[:, None] * ATTN_BLOCK + ki[None, :] - ATTN_BLOCK
    valid = ((dist >= 0) & (dist <= n_keys))[None] & (key_idx >= 0)[:, None, :]
    bias = -slopes[:, None] * (dist * dilation).astype(jnp.float32)[:, None, None, :]
    s = jnp.where(valid[None, :, :, None, None, :], s + bias, -jnp.inf)
    lse = jax.nn.logsumexp(s, axis=-1)
    p = jnp.exp(s - lse[..., None])
    o = jnp.einsum('bnqchk,bnkchd->bnqchd', p, vb)
    o = o.reshape(B, Lp, dilation, H, N)[:, :L].reshape(B, S, H, N)
    lse = lse.reshape(B, Lp, dilation, H)[:, :L].reshape(B, S, H)
    return o, lse


def _attention_mixer(qkv, q_norm, k_norm):
    B, S, _ = qkv.shape
    q = qkv[..., :D_ATTN].reshape(B, S, ATTN_HEADS, HEAD_DIM)
    k = qkv[..., D_ATTN:2 * D_ATTN].reshape(B, S, ATTN_HEADS, HEAD_DIM)
    v = qkv[..., 2 * D_ATTN:].reshape(B, S, ATTN_HEADS, HEAD_DIM)
    q = _head_rms(q, q_norm) * (HEAD_DIM ** -0.5)
    k = _head_rms(k, k_norm)
    slopes = jnp.asarray(_alibi_slopes(ATTN_HEADS), jnp.float32)
    res = [_dilated_attention(q, k, v, slopes, w, d) for (w, d) in DILATED_PATTERNS]
    outs = jnp.stack([r_[0] for r_ in res], axis=0)
    lses = jnp.stack([r_[1] for r_ in res], axis=0)
    alpha = jax.nn.softmax(lses, axis=0)
    out = jnp.sum(alpha[..., None] * outs, axis=0)
    return out.reshape(B, S, D_ATTN)


def _conv_mixer(u, dw_w, dw_b, ln_w, ln_b):
    f32 = jnp.float32
    z = u[..., :D_CONV] * jax.nn.sigmoid(u[..., D_CONV:])
    z = lax.conv_general_dilated(z, dw_w.astype(f32)[:, None, :], window_strides=(1,),
                                 padding=[(CONV_WIDTH - 1, 0)],
                                 dimension_numbers=('NWC', 'WIO', 'NWC'),
                                 feature_group_count=D_CONV) + dw_b.astype(f32)
    mu = jnp.mean(z, axis=-1, keepdims=True)
    var = jnp.mean(jnp.square(z - mu), axis=-1, keepdims=True)
    z = (z - mu) * lax.rsqrt(var + CONV_LN_EPS) * ln_w.astype(f32) + ln_b.astype(f32)
    return jax.nn.silu(z)


def setup_inputs(seed: int = 0) -> dict:
    key = jax.random.key(seed)
    ks = iter(jax.random.split(key, 40))
    f32 = jnp.float32
    L = DEPTH

    def normal(shape, scale):
        return jax.random.normal(next(ks), shape, f32) * scale

    def gain(shape):
        return 1.0 + 0.05 * jax.random.normal(next(ks), shape, f32)

    def unif(shape, lo, hi):
        return jax.random.uniform(next(ks), shape, f32, lo, hi)

    return {
        'x': normal((BATCH, SEQ, D_MODEL), 1.0),
        'norm_ffn1': gain((L, D_MODEL)),
        'ffn1_w_gate': normal((L, D_MODEL, D_FF), D_MODEL ** -0.5),
        'ffn1_w_up': normal((L, D_MODEL, D_FF), D_MODEL ** -0.5),
        'ffn1_w_down': normal((L, D_FF, D_MODEL), D_FF ** -0.5),
        'norm_mix': gain((L, D_MODEL)),
        'w_in': normal((L, D_MODEL, D_IN), D_MODEL ** -0.5),
        'shift_mu': unif((L, D_SHIFT), 0.0, 1.0),
        'rwkv_w0': unif((L, D_RWKV), -6.0, 1.0),
        'rwkv_w2': normal((L, DECAY_LORA, D_RWKV), 0.1),
        'rwkv_a0': normal((L, D_RWKV), 0.5),
        'rwkv_a2': normal((L, ICLR_LORA, D_RWKV), 0.1),
        'rwkv_g2': normal((L, GATE_LORA, D_RWKV), GATE_LORA ** -0.5),
        'rwkv_k_k': 0.85 + normal((L, D_RWKV), 0.05),
        'rwkv_k_a': gain((L, D_RWKV)),
        'rwkv_r_k': 0.5 + normal((L, RWKV_HEADS, HEAD_DIM), 0.1),
        'rwkv_ln_w': gain((L, D_RWKV)),
        'rwkv_ln_b': normal((L, D_RWKV), 0.02),
        'attn_q_norm': gain((L, HEAD_DIM)),
        'attn_k_norm': gain((L, HEAD_DIM)),
        'conv_dw_w': normal((L, CONV_WIDTH, D_CONV), CONV_WIDTH ** -0.5),
        'conv_dw_b': normal((L, D_CONV), 0.02),
        'conv_ln_w': gain((L, D_CONV)),
        'conv_ln_b': normal((L, D_CONV), 0.02),
        'w_out': normal((L, D_MIX, D_MODEL), D_MIX ** -0.5),
        'norm_ffn2': gain((L, D_MODEL)),
        'ffn2_w_gate': normal((L, D_MODEL, D_FF), D_MODEL ** -0.5),
        'ffn2_w_up': normal((L, D_MODEL, D_FF), D_MODEL ** -0.5),
        'ffn2_w_down': normal((L, D_FF, D_MODEL), D_FF ** -0.5),
    }


def reference(x, norm_ffn1, ffn1_w_gate, ffn1_w_up, ffn1_w_down, norm_mix, w_in, shift_mu,
              rwkv_w0, rwkv_w2, rwkv_a0, rwkv_a2, rwkv_g2, rwkv_k_k, rwkv_k_a, rwkv_r_k,
              rwkv_ln_w, rwkv_ln_b, attn_q_norm, attn_k_norm, conv_dw_w, conv_dw_b,
              conv_ln_w, conv_ln_b, w_out, norm_ffn2, ffn2_w_gate, ffn2_w_up, ffn2_w_down):
    for l in range(DEPTH):
        x = x + 0.5 * _swiglu(_rms_norm(x, norm_ffn1[l]), ffn1_w_gate[l], ffn1_w_up[l], ffn1_w_down[l])
        h = _rms_norm(x, norm_mix[l])
        proj = (h @ w_in[l]).astype(jnp.float32)
        p_rwkv = _token_shift(proj[..., :D_SHIFT], shift_mu[l])
        y_rwkv = _rwkv7_mixer(p_rwkv, rwkv_w0[l], rwkv_w2[l], rwkv_a0[l], rwkv_a2[l], rwkv_g2[l],
                              rwkv_k_k[l], rwkv_k_a[l], rwkv_r_k[l], rwkv_ln_w[l], rwkv_ln_b[l])
        y_attn = _attention_mixer(proj[..., D_SHIFT:D_SHIFT + 3 * D_ATTN], attn_q_norm[l], attn_k_norm[l])
        y_conv = _conv_mixer(proj[..., D_SHIFT + 3 * D_ATTN:], conv_dw_w[l], conv_dw_b[l],
                             conv_ln_w[l], conv_ln_b[l])
        mix = jnp.concatenate([y_rwkv, y_attn, y_conv], axis=-1).astype(x.dtype)
        x = x + mix @ w_out[l]
        x = x + 0.5 * _swiglu(_rms_norm(x, norm_ffn2[l]), ffn2_w_gate[l], ffn2_w_up[l], ffn2_w_down[l])
    return x
```

```cpp
#include <hip/hip_runtime.h>
#include <cstdio>
#include <cstdint>
#define MK_SINGLE 0
namespace pg8 {
#define PG8_LAS __attribute__((address_space(3)))
typedef unsigned short bf16_t;
typedef short bf16x8 __attribute__((ext_vector_type(8)));
typedef float f32x4 __attribute__((ext_vector_type(4)));
typedef unsigned u32x4 __attribute__((ext_vector_type(4)));
constexpr int BM = 256, BK = 64, HALF = 128, HTB = HALF * BK * 2  , STAGE_BYTES = 8 * HTB, NXCD = 8, WGM = 8;

__host__ __device__ __forceinline__ int lds_byte(int r, int c) { const int st = (r >> 4) * 2 + (c >> 5), rr = r & 15, cc = c & 31, ob = rr * 64 + cc * 2; return st * 1024 + (ob ^ (((ob >> 9) & 1) << 5)); }
__host__ __device__ __forceinline__ void stage_rc(int b, int& R, int& C) { const int st = b / 1024, sb = b % 1024, swz = sb ^ (((sb >> 9) & 1) << 5); R = (st >> 1) * 16 + swz / 64; C = (st & 1) * 32 + (swz % 64) / 2; }
__host__ __device__ __forceinline__ int perm32(int rho) { const int n = rho >> 4, i = rho & 15; return 8 * (i >> 2) + 4 * n + (i & 3); }

struct Unit { int pm, pn; };
struct Gemm { const bf16_t* A; const bf16_t* Bt; int M, N, K; };

struct StaticOrder {
    int nM, nN, nwg, G, c;
    __host__ __device__ void init(int M, int N, int G_, int c_) { nM = M / BM; nN = N / BM; nwg = nM * nN; G = G_; c = c_; }
    __host__ __device__ bool next(int i, Unit& u) const {
        const long L = (long)i * G + c; if (L >= nwg) return false;
        int wgid = (int)L; { const int q = nwg / NXCD, r = nwg % NXCD, xcd = wgid % NXCD, off = wgid / NXCD; wgid = (xcd < r ? xcd * (q + 1) : r * (q + 1) + (xcd - r) * q) + off; }
        const int nig = WGM * nN, gid = wgid / nig, fm = gid * WGM, gsz = (nM - fm) < WGM ? (nM - fm) : WGM;
        u.pm = fm + ((wgid % nig) % gsz); u.pn = (wgid % nig) / gsz; return true;
    }
    __device__ __forceinline__ void a_ready(const Unit&) const {}
    __device__ __forceinline__ void done(const Unit&) const {}
};

__device__ __forceinline__ unsigned cvt_pk_bf16(float lo, float hi) { unsigned r; asm volatile("v_cvt_pk_bf16_f32 %0, %1, %2" : "=v"(r) : "v"(lo), "v"(hi)); return r; }
typedef float f32x2 __attribute__((ext_vector_type(2)));

__device__ __forceinline__ float row_scale(const float* rowsq, int row) {
    const f32x4* p = (const f32x4*)(rowsq + (size_t)row * 16);
    const f32x4 a = p[0], b = p[1], c = p[2], d = p[3];
    const float s = ((a[0] + a[1]) + (a[2] + a[3])) + ((b[0] + b[1]) + (b[2] + b[3])) + ((c[0] + c[1]) + (c[2] + c[3])) + ((d[0] + d[1]) + (d[2] + d[3]));
    return __builtin_amdgcn_rsqf(s * (1.0f / 1024.0f) + 1e-6f);
}
__device__ __forceinline__ float silu_f(float x) { return x * __builtin_amdgcn_rcpf(1.0f + __expf(-x)); }

struct EpiSwiglu {
    static constexpr bool PERM = true, AFTER_DRAIN = false;
    bf16_t* H; int ldh; const float* rowsq;
    __device__ __forceinline__ void operator()(const f32x4 (&acc)[2][2][4][2], const Unit& u, int wr, int wc, int fr, int fq) const {
        const int row0 = u.pm * BM + wr * 64 + fr, col0 = u.pn * HALF + wc * 32 + 8 * fq;
#pragma unroll
        for (int ai = 0; ai < 2; ++ai)
#pragma unroll
            for (int m = 0; m < 4; ++m) {
                const int row = row0 + ai * HALF + m * 16; const float s = row_scale(rowsq, row);
                float h[8];
#pragma unroll
                for (int n = 0; n < 2; ++n)
#pragma unroll
                    for (int j = 0; j < 4; ++j) { const float g = acc[ai][0][m][n][j] * s, up = acc[ai][1][m][n][j] * s; h[4 * n + j] = silu_f(g) * up; }
                u32x4 w; w.x = cvt_pk_bf16(h[0], h[1]); w.y = cvt_pk_bf16(h[2], h[3]); w.z = cvt_pk_bf16(h[4], h[5]); w.w = cvt_pk_bf16(h[6], h[7]);
                *(u32x4*)(H + (size_t)row * ldh + col0) = w;
            }
    }
};
struct EpiProj {
    static constexpr bool PERM = true, AFTER_DRAIN = false;
    bf16_t* O; int ldc; const float* rowsq;
    __device__ __forceinline__ void operator()(const f32x4 (&acc)[2][2][4][2], const Unit& u, int wr, int wc, int fr, int fq) const {
        const int row0 = u.pm * BM + wr * 64 + fr, col0 = u.pn * BM + wc * 32 + 8 * fq;
#pragma unroll
        for (int ai = 0; ai < 2; ++ai)
#pragma unroll
            for (int m = 0; m < 4; ++m) {
                const int row = row0 + ai * HALF + m * 16; const float s = row_scale(rowsq, row);
#pragma unroll
                for (int bj = 0; bj < 2; ++bj) { const f32x4 v0 = acc[ai][bj][m][0] * s, v1 = acc[ai][bj][m][1] * s;
                    u32x4 w; w.x = cvt_pk_bf16(v0[0], v0[1]); w.y = cvt_pk_bf16(v0[2], v0[3]); w.z = cvt_pk_bf16(v1[0], v1[1]); w.w = cvt_pk_bf16(v1[2], v1[3]);
                    *(u32x4*)(O + (size_t)row * ldc + col0 + bj * HALF) = w; }
            }
    }
};
struct EpiResidual {
    static constexpr bool PERM = true, AFTER_DRAIN = false;
    const float* base; float* out; bf16_t* xb; float* rowsq; int ldc;
    __device__ __forceinline__ void operator()(const f32x4 (&acc)[2][2][4][2], const Unit& u, int wr, int wc, int fr, int fq) const {
        const int row0 = u.pm * BM + wr * 64 + fr, col0 = u.pn * BM + wc * 32 + 8 * fq;
#pragma unroll
        for (int ai = 0; ai < 2; ++ai)
#pragma unroll
            for (int m = 0; m < 4; ++m) {
                const int row = row0 + ai * HALF + m * 16; float ss = 0.f;
#pragma unroll
                for (int bj = 0; bj < 2; ++bj) { const size_t off = (size_t)row * ldc + col0 + bj * HALF;
                    const f32x4 b0 = *(const f32x4*)(base + off), b1 = *(const f32x4*)(base + off + 4);
                    const f32x4 v0 = b0 + acc[ai][bj][m][0], v1 = b1 + acc[ai][bj][m][1];
                    *(f32x4*)(out + off) = v0; *(f32x4*)(out + off + 4) = v1;
                    ss += (v0[0] * v0[0] + v0[1] * v0[1]) + (v0[2] * v0[2] + v0[3] * v0[3]) + (v1[0] * v1[0] + v1[1] * v1[1]) + (v1[2] * v1[2] + v1[3] * v1[3]);
                    u32x4 w; w.x = cvt_pk_bf16(v0[0], v0[1]); w.y = cvt_pk_bf16(v0[2], v0[3]); w.z = cvt_pk_bf16(v1[0], v1[1]); w.w = cvt_pk_bf16(v1[2], v1[3]);
                    *(u32x4*)(xb + off) = w; }
                ss += __shfl_xor(ss, 16); ss += __shfl_xor(ss, 32);
                if (fq == 0) rowsq[(size_t)row * 16 + u.pn * 4 + wc] = ss;
            }
    }
};


template <class Epi, class Sched, bool ALIGN_EPI = false, bool SP2 = false>
__device__ __forceinline__ void gemm_phase(PG8_LAS unsigned char* lds, const Gemm g, const Sched& S, const Epi& E) {
    int tid_ = threadIdx.x; asm volatile("" : "+v"(tid_));
    const int tid = tid_, wid = __builtin_amdgcn_readfirstlane(tid >> 6), lane = tid & 63, wr = wid >> 2, wc = wid & 3, fr = lane & 15, fq = lane >> 4;
    const int K = g.K, nt = K / BK;
    unsigned voffA[2], voffB[2];
#pragma unroll
    for (int i = 0; i < 2; ++i) { int R, C; stage_rc(tid * 16 + i * 8192, R, C); const int Rb = Epi::PERM ? ((R & ~31) + perm32(R & 31)) : R;
        voffA[i] = (unsigned)(R * K + C) * 2u; voffB[i] = (unsigned)(Rb * K + C) * 2u; }
    const size_t kstep = (size_t)(BK * 2);
    const size_t hstep = (size_t)HALF * K * 2;
    const size_t tstep = 2 * hstep;
    const unsigned ldsw = (unsigned)wid * 1024u;
    const int aoff = lds_byte(wr * 64 + fr, fq * 8), boff = lds_byte(wc * 32 + fr, fq * 8);
#define PG8_SA(b, h) (((b) * 2 + (h)) * HTB)
#define PG8_SB(b, h) ((4 + (b) * 2 + (h)) * HTB)
#define PG8_STAGE(bufoff, gbase, voff) do { _Pragma("unroll") for (int _i = 0; _i < 2; ++_i) \
        __builtin_amdgcn_global_load_lds((const unsigned*)((const char*)(gbase) + (voff)[_i]), (PG8_LAS unsigned*)(lds + (bufoff) + ldsw + _i * 8192), 16, 0, 0); } while (0)
#define PG8_LDA(dst, b, h) do { _Pragma("unroll") for (int m = 0; m < 4; ++m) _Pragma("unroll") for (int k = 0; k < 2; ++k) dst[m][k] = *(const PG8_LAS bf16x8*)(lds + PG8_SA(b, h) + aoff + m * 2048 + k * 1024); } while (0)
#define PG8_LDB(dst, b, h) do { _Pragma("unroll") for (int n = 0; n < 2; ++n) _Pragma("unroll") for (int k = 0; k < 2; ++k) dst[n][k] = *(const PG8_LAS bf16x8*)(lds + PG8_SB(b, h) + boff + n * 2048 + k * 1024); } while (0)
#define PG8_MMA(ai, bj, At, Bt) do { __builtin_amdgcn_s_setprio(1); _Pragma("unroll") for (int m = 0; m < 4; ++m) _Pragma("unroll") for (int n = 0; n < 2; ++n) _Pragma("unroll") for (int k = 0; k < 2; ++k) \
        acc[ai][bj][m][n] = __builtin_amdgcn_mfma_f32_16x16x32_bf16(Bt[n][k], At[m][k], acc[ai][bj][m][n], 0, 0, 0); __builtin_amdgcn_s_setprio(0); } while (0)
#define PG8_WAIT_V(n) asm volatile("s_waitcnt vmcnt(" #n ")" ::: "memory")
#define PG8_WAIT_L(n) asm volatile("s_waitcnt lgkmcnt(" #n ")" ::: "memory")
#define PG8_BAR __builtin_amdgcn_s_barrier()
#define PG8_SCHED __builtin_amdgcn_sched_barrier(0)
    Unit cur, nxt; int ui = 0;
    if (!S.next(0, cur)) return;
    f32x4 acc[2][2][4][2];
#pragma unroll
    for (int a = 0; a < 2; ++a)
#pragma unroll
        for (int b = 0; b < 2; ++b)
#pragma unroll
            for (int m = 0; m < 4; ++m)
#pragma unroll
                for (int n = 0; n < 2; ++n) acc[a][b][m][n] = (f32x4){0.f, 0.f, 0.f, 0.f};
    bf16x8 At[4][2], B0[2][2], B1[2][2];
    const char* cA = (const char*)g.A + (size_t)cur.pm * tstep; const char* cB = (const char*)g.Bt + (size_t)cur.pn * tstep;
    S.a_ready(cur);
    if constexpr (SP2) {
        PG8_STAGE(PG8_SB(0, 0), cB, voffB); PG8_STAGE(PG8_SB(0, 1), cB + hstep, voffB); PG8_STAGE(PG8_SA(0, 0), cA, voffA); PG8_STAGE(PG8_SA(0, 1), cA + hstep, voffA);
        if (wr == 1) PG8_BAR;
        PG8_WAIT_V(2); PG8_BAR;
        PG8_STAGE(PG8_SB(1, 0), cB + kstep, voffB); PG8_STAGE(PG8_SA(1, 0), cA + kstep, voffA); PG8_STAGE(PG8_SB(1, 1), cB + hstep + kstep, voffB);
        PG8_WAIT_V(6); PG8_BAR;
    } else {
        PG8_STAGE(PG8_SB(0, 0), cB, voffB); PG8_STAGE(PG8_SA(0, 0), cA, voffA); PG8_STAGE(PG8_SB(0, 1), cB + hstep, voffB); PG8_STAGE(PG8_SA(0, 1), cA + hstep, voffA);
        if (wr == 1) PG8_BAR;
        PG8_WAIT_V(4); PG8_BAR;
        PG8_STAGE(PG8_SB(1, 0), cB + kstep, voffB); PG8_STAGE(PG8_SA(1, 0), cA + kstep, voffA); PG8_STAGE(PG8_SB(1, 1), cB + hstep + kstep, voffB);
        PG8_WAIT_V(6); PG8_BAR;
    }
    for (;;) {
        const bool has_next = S.next(ui + 1, nxt);
        const char* nA = has_next ? (const char*)g.A + (size_t)nxt.pm * tstep : cA; const char* nB = has_next ? (const char*)g.Bt + (size_t)nxt.pn * tstep : cB;
        for (int t = 0; t < nt; t += 2) {
            const bool last = (t == nt - 2);
            const char* a1 = cA + (size_t)(t + 1) * kstep;
            const char* a2 = last ? nA : cA + (size_t)(t + 2) * kstep; const char* b2 = last ? nB : cB + (size_t)(t + 2) * kstep;
            const char* a3 = a2 + kstep; const char* b3 = b2 + kstep;
            if (last && has_next) S.a_ready(nxt);
            if constexpr (SP2) {
            PG8_LDB(B0, 0, 0); PG8_LDB(B1, 0, 1); PG8_SCHED; PG8_LDA(At, 0, 0); PG8_STAGE(PG8_SA(1, 1), a1 + hstep, voffA);
            PG8_WAIT_V(8); PG8_WAIT_L(0); PG8_BAR; PG8_MMA(0, 0, At, B0); PG8_MMA(0, 1, At, B1); PG8_BAR; PG8_SCHED;
            PG8_LDA(At, 0, 1); PG8_STAGE(PG8_SB(0, 0), b2, voffB); PG8_STAGE(PG8_SB(0, 1), b2 + hstep, voffB); PG8_STAGE(PG8_SA(0, 0), a2, voffA);
            PG8_WAIT_V(8); PG8_WAIT_L(0); PG8_BAR; PG8_MMA(1, 0, At, B0); PG8_MMA(1, 1, At, B1); PG8_BAR; PG8_SCHED;
            PG8_LDB(B0, 1, 0); PG8_LDB(B1, 1, 1); PG8_SCHED; PG8_LDA(At, 1, 0); PG8_STAGE(PG8_SA(0, 1), a2 + hstep, voffA);
            PG8_WAIT_V(8); PG8_WAIT_L(0); PG8_BAR; PG8_MMA(0, 0, At, B0); PG8_MMA(0, 1, At, B1); PG8_BAR; PG8_SCHED;
            PG8_LDA(At, 1, 1); PG8_STAGE(PG8_SB(1, 0), b3, voffB); PG8_STAGE(PG8_SB(1, 1), b3 + hstep, voffB); PG8_STAGE(PG8_SA(1, 0), a3, voffA);
            PG8_WAIT_V(8); PG8_WAIT_L(0); PG8_BAR; PG8_MMA(1, 0, At, B0); PG8_MMA(1, 1, At, B1); PG8_BAR; PG8_SCHED;
            } else {
            PG8_LDB(B0, 0, 0); PG8_SCHED; PG8_LDA(At, 0, 0); PG8_STAGE(PG8_SA(1, 1), a1 + hstep, voffA);
            PG8_WAIT_L(8); PG8_BAR; PG8_WAIT_L(0); PG8_MMA(0, 0, At, B0); PG8_BAR; PG8_SCHED;
            PG8_LDB(B1, 0, 1); PG8_STAGE(PG8_SB(0, 0), b2, voffB);
            PG8_BAR; PG8_WAIT_L(0); PG8_MMA(0, 1, At, B1); PG8_BAR;
            PG8_LDA(At, 0, 1); PG8_STAGE(PG8_SA(0, 0), a2, voffA);
            PG8_BAR; PG8_WAIT_L(0); PG8_MMA(1, 0, At, B0); PG8_BAR; PG8_SCHED;
            PG8_STAGE(PG8_SB(0, 1), b2 + hstep, voffB);
            PG8_WAIT_V(6); PG8_BAR; PG8_MMA(1, 1, At, B1); PG8_BAR;
            PG8_LDB(B0, 1, 0); PG8_SCHED; PG8_LDA(At, 1, 0); PG8_STAGE(PG8_SA(0, 1), a2 + hstep, voffA);
            PG8_WAIT_L(8); PG8_BAR; PG8_WAIT_L(0); PG8_MMA(0, 0, At, B0); PG8_BAR; PG8_SCHED;
            PG8_LDB(B1, 1, 1); PG8_STAGE(PG8_SB(1, 0), b3, voffB);
            PG8_BAR; PG8_WAIT_L(0); PG8_MMA(0, 1, At, B1); PG8_BAR;
            PG8_LDA(At, 1, 1); PG8_STAGE(PG8_SA(1, 0), a3, voffA);
            PG8_BAR; PG8_WAIT_L(0); PG8_MMA(1, 0, At, B0); PG8_BAR; PG8_SCHED;
            PG8_STAGE(PG8_SB(1, 1), b3 + hstep, voffB);
            PG8_WAIT_V(6); PG8_BAR; PG8_MMA(1, 1, At, B1); PG8_BAR;
            }
        }
        if constexpr (ALIGN_EPI) { if (wr == 0) PG8_BAR; }
        if constexpr (!Epi::AFTER_DRAIN) { E(acc, cur, wr, wc, fr, fq); S.done(cur); }
        if (!has_next) break;
#pragma unroll
        for (int a = 0; a < 2; ++a)
#pragma unroll
            for (int b = 0; b < 2; ++b)
#pragma unroll
                for (int m = 0; m < 4; ++m)
#pragma unroll
                    for (int n = 0; n < 2; ++n) acc[a][b][m][n] = (f32x4){0.f, 0.f, 0.f, 0.f};
        cur = nxt; cA = nA; cB = nB; ++ui;
        if constexpr (ALIGN_EPI) { if (wr == 1) PG8_BAR; }
    }
    PG8_WAIT_V(0);
    if constexpr (!ALIGN_EPI) { if (wr == 0) PG8_BAR; }
    PG8_BAR;
    if constexpr (Epi::AFTER_DRAIN) { E.fused(acc, cur, wr, wc, fr, fq, lds, wid, lane); S.done(cur); }
#undef PG8_SA
#undef PG8_SB
#undef PG8_STAGE
#undef PG8_LDA
#undef PG8_LDB
#undef PG8_MMA
#undef PG8_WAIT_V
#undef PG8_WAIT_L
#undef PG8_BAR
#undef PG8_SCHED
}
}

constexpr int NWAVES = 8;
constexpr int BATCH = 8, SEQ = 4096, DM = 1024, DEPTH = 4, M = BATCH * SEQ;
constexpr int FF = 2816, NUP = 2 * FF, DIN = 2944, PP = 3072;
constexpr int DR = 384, NH = 6, HD = 64, DSHIFT = 1280, DC = 256, CW = 31;
constexpr int C_R = 0, C_K = 384, C_V = 768, C_XW = 1152, C_XA = 1184, C_XG = 1216, C_Q = 1280, C_AK = 1664, C_AV = 2048, C_CU = 2432, C_CG = 2688;
constexpr int NPH = 10;
constexpr float LOG2E = 1.4426950408889634f;
enum { I_X = 0, I_NF1, I_WG1, I_WU1, I_WD1, I_NMIX, I_WIN, I_MU, I_W0, I_W2, I_A0, I_A2, I_G2, I_KK, I_KA, I_RK, I_LNW, I_LNB, I_QN, I_KN, I_CW, I_CB, I_CLW, I_CLB, I_WOUT, I_NF2, I_WG2, I_WU2, I_WD2, N_IN };

constexpr size_t MiB = 1u << 20;
constexpr size_t WS_CTL = 0, CTL_ZERO_BYTES = 1 * MiB;
constexpr size_t WS_LORA = 2 * MiB;
constexpr size_t WS_W = 4 * MiB;
constexpr size_t W_UP1 = WS_W, W_DN1 = W_UP1 + (size_t)NUP * DM * 2, W_IN = W_DN1 + (size_t)DM * FF * 2, W_OUT = W_IN + (size_t)PP * DM * 2,
                 W_UP2 = W_OUT + (size_t)DM * DM * 2, W_DN2 = W_UP2 + (size_t)NUP * DM * 2, W_END = W_DN2 + (size_t)DM * FF * 2;
constexpr size_t WS_XB = 48 * MiB;
constexpr size_t WS_PH = 112 * MiB;
constexpr size_t WS_MIX = 304 * MiB;
constexpr size_t WS_RSQ = 368 * MiB;
constexpr size_t WS_RWE = 370 * MiB, WS_RWA = 394 * MiB, WS_RWK = 418 * MiB, WS_RWG = 442 * MiB;
constexpr size_t WS_END = 466 * MiB;
constexpr size_t WS_AP1 = WS_XB, WS_AP2 = WS_XB + 24 * MiB, WS_ADEN = WS_XB + 48 * MiB;
static_assert(W_END <= WS_XB && WS_ADEN + 3ull * M * 8 * 4 <= WS_PH && WS_PH + (size_t)M * PP * 2 <= WS_MIX && WS_MIX + (size_t)M * DM * 2 <= WS_RSQ && WS_RSQ + (size_t)M * 16 * 4 <= WS_RWE && WS_RWG + (size_t)M * DR * 2 <= WS_END, "d_ws map");
constexpr int CW_BAR = 4096;

constexpr int RING_OFF = 0, RING_BYTES = 131072;
constexpr int LDSCTL_OFF = RING_BYTES, MISC_OFF = LDSCTL_OFF + 320;
constexpr int LDS_BYTES = 147456;

#define GAS __attribute__((address_space(1)))
#define LAS __attribute__((address_space(3)))
#define DI __device__ __forceinline__
typedef unsigned short bf16;
typedef unsigned v4u __attribute__((ext_vector_type(4)));
typedef unsigned v2u __attribute__((ext_vector_type(2)));
typedef float f32x4 __attribute__((ext_vector_type(4)));
typedef short bf16x8 __attribute__((ext_vector_type(8)));
typedef short v4i16_t __attribute__((ext_vector_type(4)));
typedef GAS unsigned gu32;
#define RLX_AGENT __ATOMIC_RELAXED, __HIP_MEMORY_SCOPE_AGENT
#define LDS_WAIT() asm volatile("s_waitcnt lgkmcnt(0)" ::: "memory")
DI unsigned f2bf(float f) { unsigned u = __builtin_bit_cast(unsigned, f); return (u + 0x7fffu + ((u >> 16) & 1u)) >> 16; }
DI unsigned pk2(float lo, float hi) { return pg8::cvt_pk_bf16(lo, hi); }
DI float bflo(unsigned w) { return __builtin_bit_cast(float, w << 16); }
DI float bfhi(unsigned w) { return __builtin_bit_cast(float, w & 0xffff0000u); }
DI float bf1(bf16 h) { return __builtin_bit_cast(float, (unsigned)h << 16); }
DI void unpack8(const v4u w, float (&f)[8]) { f[0] = bflo(w.x); f[1] = bfhi(w.x); f[2] = bflo(w.y); f[3] = bfhi(w.y); f[4] = bflo(w.z); f[5] = bfhi(w.z); f[6] = bflo(w.w); f[7] = bfhi(w.w); }
DI v4u pack8(const float (&f)[8]) { v4u w; w.x = pk2(f[0], f[1]); w.y = pk2(f[2], f[3]); w.z = pk2(f[4], f[5]); w.w = pk2(f[6], f[7]); return w; }
DI void unpack4(const v2u w, float (&f)[4]) { f[0] = bflo(w.x); f[1] = bfhi(w.x); f[2] = bflo(w.y); f[3] = bfhi(w.y); }
DI float sigmoid_f(float x) { return __builtin_amdgcn_rcpf(1.0f + __expf(-x)); }
DI float silu_x(float x) { return x * sigmoid_f(x); }
DI float tanh_f(float x) { const float e = __expf(-2.0f * fabsf(x)); const float t = (1.0f - e) * __builtin_amdgcn_rcpf(1.0f + e); return x < 0.f ? -t : t; }

#define XB_TMO      128
#define XB_XCNT(j)  (256  + 64 * (j))
#define XB_XSUB(j)  (1280 + 64 * (j))
#define XB_XGEN(j)  (2304 + 64 * (j))
#define XB_TOP      3328
#define XB_TOPGEN   3392
#define XCD_BAR_WORDS 3456
#define XB_SPIN_CAP (1u << 18)

__device__ __forceinline__ unsigned xb_ld(unsigned* p)              { return __hip_atomic_load(p, __ATOMIC_RELAXED, __HIP_MEMORY_SCOPE_AGENT); }
__device__ __forceinline__ unsigned xb_add(unsigned* p, unsigned v) { return __hip_atomic_fetch_add(p, v, __ATOMIC_RELAXED, __HIP_MEMORY_SCOPE_AGENT); }
__device__ __forceinline__ unsigned xb_xcc_id() { return (unsigned)__builtin_amdgcn_s_getreg((3 << 11) | 20) & 0xFu; }
#define XB_SPIN(cond, bar) do { unsigned _sp = 0; while (cond) { __builtin_amdgcn_s_sleep(1); \
    if ((++_sp & 255u) == 0u) { if (xb_ld(&(bar)[XB_TMO])) break; if (_sp > XB_SPIN_CAP) { atomicAdd(&(bar)[XB_TMO], 1u); break; } } } } while (0)

struct XcdBarrier {
    unsigned* bar; unsigned x;
    volatile LAS unsigned* st;
};

__device__ __forceinline__ XcdBarrier xcd_barrier_post(unsigned* bar, volatile LAS unsigned* st) {
    XcdBarrier b; b.bar = bar; b.x = xb_xcc_id(); b.st = st;
    if (threadIdx.x == 0) (void)xb_add(&bar[XB_XCNT(b.x)], 1u);
    return b;
}
__device__ __forceinline__ void xcd_barrier_complete(unsigned* bar, unsigned x, unsigned& nloc, unsigned& nx) {
    const unsigned G = gridDim.x * gridDim.y * gridDim.z;
    unsigned sum, cnt, mine, sp = 0u;
    for (;;) {
        sum = 0u; cnt = 0u; mine = 0u;
#pragma unroll
        for (unsigned j = 0; j < 16; ++j) { const unsigned c = xb_ld(&bar[XB_XCNT(j)]); sum += c; cnt += (c > 0u) ? 1u : 0u; mine = (j == x) ? c : mine; }
        if (sum == G) break;
        __builtin_amdgcn_s_sleep(1);
        if ((++sp & 255u) == 0u) { if (xb_ld(&bar[XB_TMO])) break; if (sp > XB_SPIN_CAP) { atomicAdd(&bar[XB_TMO], 1u); break; } }
    }
    nloc = mine > 0u ? mine : 1u; nx = cnt > 0u ? cnt : 1u;
}

__device__ __forceinline__ void xcd_barrier(const XcdBarrier& b) {
    asm volatile("s_waitcnt vmcnt(0)" ::: "memory");
    __syncthreads();
    if (threadIdx.x == 0) {
        unsigned* bar = b.bar;
        __builtin_amdgcn_s_waitcnt(0);
        unsigned nloc = b.st[0], nx = b.st[1];
        if (nloc == 0u) { xcd_barrier_complete(bar, b.x, nloc, nx); b.st[0] = nloc; b.st[1] = nx; }
        const unsigned old = xb_add(&bar[XB_XSUB(b.x)], 1u);
        const unsigned gen = old / nloc;
        if (old + 1u == (gen + 1u) * nloc) {
            __builtin_amdgcn_fence(__ATOMIC_RELEASE, "agent");
            asm volatile("s_waitcnt vmcnt(0)" ::: "memory");
            const unsigned og = xb_add(&bar[XB_TOP], 1u);
            const unsigned tg = og / nx;
            if (og + 1u == (tg + 1u) * nx) xb_add(&bar[XB_TOPGEN], 1u);
            else XB_SPIN(xb_ld(&bar[XB_TOPGEN]) == tg, bar);
            __builtin_amdgcn_fence(__ATOMIC_ACQUIRE, "agent");
            xb_add(&bar[XB_XGEN(b.x)], 1u);
            asm volatile("s_waitcnt vmcnt(0)" ::: "memory");
        } else {
            XB_SPIN(xb_ld(&bar[XB_XGEN(b.x)]) == gen, bar);
            __builtin_amdgcn_fence(__ATOMIC_ACQUIRE, "agent");
            asm volatile("s_waitcnt vmcnt(0)" ::: "memory");
        }
    }
    __syncthreads();
}

struct Args { const float* in[N_IN]; float* out; unsigned char* ws; int l_lo, l_hi, ph_lo, ph_hi, single, pad; };
struct Frame {
    LAS unsigned char* lds;
    volatile LAS unsigned* MISC;
    gu32* ctl;
    int tid, lane, wave, G, bid;
};
DI float wave_sum(float v) {
#pragma unroll
    for (int o = 1; o < 64; o <<= 1) v += __shfl_xor(v, o);
    return v;
}
DI float wave_max(float v) {
#pragma unroll
    for (int o = 1; o < 64; o <<= 1) v = fmaxf(v, __shfl_xor(v, o));
    return v;
}
DI float row16_sum(float v) {
    v += __builtin_bit_cast(float, __builtin_amdgcn_mov_dpp(__builtin_bit_cast(int, v), 0xB1, 0xF, 0xF, true));
    v += __builtin_bit_cast(float, __builtin_amdgcn_mov_dpp(__builtin_bit_cast(int, v), 0x4E, 0xF, 0xF, true));
    v += __builtin_bit_cast(float, __builtin_amdgcn_mov_dpp(__builtin_bit_cast(int, v), 0x141, 0xF, 0xF, true));
    v += __builtin_bit_cast(float, __builtin_amdgcn_mov_dpp(__builtin_bit_cast(int, v), 0x140, 0xF, 0xF, true));
    return v;
}

DI void tr_item(const float* W, int K, int N, const float* ksc, float cs, bf16* WT, int drow0, LAS float* scr, int kb, int nb, int lane) {
    const int k0 = 64 * kb, n0 = 32 * nb;
#pragma unroll 8
    for (int i = 0; i < 32; ++i) { const int kk = 2 * i + (lane >> 5); const float sc = ksc ? ksc[k0 + kk] * cs : cs;
        scr[kk * 33 + (lane & 31)] = W[(size_t)(k0 + kk) * N + n0 + (lane & 31)] * sc; }
    LDS_WAIT(); asm volatile("" ::: "memory");
    const int c = lane & 7;
#pragma unroll
    for (int j = 0; j < 4; ++j) { const int n = (lane >> 3) + 8 * j; const LAS float* s = scr + (8 * c) * 33 + n;
        v4u o; o.x = pk2(s[0 * 33], s[1 * 33]); o.y = pk2(s[2 * 33], s[3 * 33]); o.z = pk2(s[4 * 33], s[5 * 33]); o.w = pk2(s[6 * 33], s[7 * 33]);
        *(GAS v4u*)(WT + (size_t)(drow0 + n) * K + k0 + 8 * c) = o; }
    LDS_WAIT(); asm volatile("" ::: "memory");
}
DI int glu_row(int nb, int up) { const int n0 = 32 * nb; return (n0 >> 7) * 256 + (n0 & 127) + up * 128; }
DI void phase0(const Frame& F, const Args& a, int l) {
    LAS float* scr = (LAS float*)(F.lds + RING_OFF + F.wave * 16384);
    const int gw = F.bid * NWAVES + F.wave, NGW = F.G * NWAVES;
    unsigned char* ws = a.ws;
    const float* nf1 = a.in[I_NF1] + (size_t)l * DM; const float* nmx = a.in[I_NMIX] + (size_t)l * DM; const float* nf2 = a.in[I_NF2] + (size_t)l * DM;
    const float* wg1 = a.in[I_WG1] + (size_t)l * DM * FF; const float* wu1 = a.in[I_WU1] + (size_t)l * DM * FF; const float* wd1 = a.in[I_WD1] + (size_t)l * FF * DM;
    const float* wg2 = a.in[I_WG2] + (size_t)l * DM * FF; const float* wu2 = a.in[I_WU2] + (size_t)l * DM * FF; const float* wd2 = a.in[I_WD2] + (size_t)l * FF * DM;
    const float* win = a.in[I_WIN] + (size_t)l * DM * DIN; const float* wout = a.in[I_WOUT] + (size_t)l * DM * DM;
    constexpr int I_GU = 16 * 88, I_DN = 44 * 32, I_IN = 16 * 92, I_OUT = 16 * 32, NITEMS = 4 * I_GU + 2 * I_DN + I_IN + I_OUT;
    for (int it = gw; it < NITEMS; it += NGW) {
        int r = it;
        if (r < I_GU) { tr_item(wg1, DM, FF, nf1, 1.f, (bf16*)(ws + W_UP1), glu_row(r % 88, 0), scr, r / 88, r % 88, F.lane); continue; } r -= I_GU;
        if (r < I_GU) { tr_item(wu1, DM, FF, nf1, 1.f, (bf16*)(ws + W_UP1), glu_row(r % 88, 1), scr, r / 88, r % 88, F.lane); continue; } r -= I_GU;
        if (r < I_DN) { tr_item(wd1, FF, DM, nullptr, 0.5f, (bf16*)(ws + W_DN1), 32 * (r % 32), scr, r / 32, r % 32, F.lane); continue; } r -= I_DN;
        if (r < I_IN) { tr_item(win, DM, DIN, nmx, 1.f, (bf16*)(ws + W_IN), 32 * (r % 92), scr, r / 92, r % 92, F.lane); continue; } r -= I_IN;
        if (r < I_OUT) { tr_item(wout, DM, DM, nullptr, 1.f, (bf16*)(ws + W_OUT), 32 * (r % 32), scr, r / 32, r % 32, F.lane); continue; } r -= I_OUT;
        if (r < I_GU) { tr_item(wg2, DM, FF, nf2, 1.f, (bf16*)(ws + W_UP2), glu_row(r % 88, 0), scr, r / 88, r % 88, F.lane); continue; } r -= I_GU;
        if (r < I_GU) { tr_item(wu2, DM, FF, nf2, 1.f, (bf16*)(ws + W_UP2), glu_row(r % 88, 1), scr, r / 88, r % 88, F.lane); continue; } r -= I_GU;
        tr_item(wd2, FF, DM, nullptr, 0.5f, (bf16*)(ws + W_DN2), 32 * (r % 32), scr, r / 32, r % 32, F.lane);
    }
    const int gt = F.bid * (NWAVES * 64) + F.tid, NGT = F.G * NWAVES * 64;
    for (int i = gt; i < (PP - DIN) * DM * 2 / 16; i += NGT) ((GAS v4u*)(ws + W_IN + (size_t)DIN * DM * 2))[i] = (v4u){0u, 0u, 0u, 0u};
    const float* w2 = a.in[I_W2] + (size_t)l * 32 * DR; const float* a2 = a.in[I_A2] + (size_t)l * 32 * DR; const float* g2 = a.in[I_G2] + (size_t)l * 64 * DR;
    bf16* lf = (bf16*)(ws + WS_LORA);
    for (int i = gt; i < 6144; i += NGT) {
        const float* src; int nt, ks, ln;
        if (i < 1536) { src = w2; nt = i >> 6; ks = 0; ln = i & 63; }
        else if (i < 3072) { src = a2; nt = (i - 1536) >> 6; ks = 0; ln = i & 63; }
        else { src = g2; const int ii = i - 3072; nt = ii >> 7; ks = (ii >> 6) & 1; ln = ii & 63; }
        const int n = ln & 15, q = ln >> 4; float f[8];
#pragma unroll
        for (int j = 0; j < 8; ++j) f[j] = src[(size_t)(32 * ks + 8 * q + j) * DR + 16 * nt + n];
        *(GAS v4u*)(lf + (size_t)i * 8) = pack8(f);
    }
    if (l == 0) {
        const float* x = a.in[I_X]; bf16* xb = (bf16*)(ws + WS_XB); float* rsq = (float*)(ws + WS_RSQ);
        for (int row = gw; row < M; row += NGW) {
            const GAS f32x4* xr = (const GAS f32x4*)(x + (size_t)row * DM) + F.lane; float ss = 0.f;
            GAS v2u* o8 = (GAS v2u*)(xb + (size_t)row * DM) + F.lane;
#pragma unroll
            for (int j = 0; j < 4; ++j) { const f32x4 v = xr[64 * j]; ss += (v[0] * v[0] + v[1] * v[1]) + (v[2] * v[2] + v[3] * v[3]); v2u w; w.x = pk2(v[0], v[1]); w.y = pk2(v[2], v[3]); o8[64 * j] = w; }
            ss = wave_sum(ss);
            if (F.lane < 16) rsq[(size_t)row * 16 + F.lane] = (F.lane == 0) ? ss : 0.f;
        }
    }
}

DI void shift8(const bf16* pr, bool has_prev, int col, const float* mu, float (&o)[8]) {
    const v4u c = *(const GAS v4u*)(pr + col); v4u p = (v4u){0u, 0u, 0u, 0u}; if (has_prev) p = *(const GAS v4u*)(pr - PP + col);
    float fc[8], fp[8]; unpack8(c, fc); unpack8(p, fp);
    const f32x4 m0 = *(const GAS f32x4*)(mu + col), m1 = *(const GAS f32x4*)(mu + col + 4);
#pragma unroll
    for (int j = 0; j < 8; ++j) { const float m = j < 4 ? m0[j] : m1[j - 4]; o[j] = fc[j] + (fp[j] - fc[j]) * m; }
}
DI void shift4(const bf16* pr, bool has_prev, int col, const float* mu, float (&o)[4]) {
    const v2u c = *(const GAS v2u*)(pr + col); v2u p = (v2u){0u, 0u}; if (has_prev) p = *(const GAS v2u*)(pr - PP + col);
    float fc[4], fp[4]; unpack4(c, fc); unpack4(p, fp);
    const f32x4 m0 = *(const GAS f32x4*)(mu + col);
#pragma unroll
    for (int j = 0; j < 4; ++j) o[j] = fc[j] + (fp[j] - fc[j]) * m0[j];
}
DI void rwkv_prep_unit(const Frame& F, const Args& a, int l, int wu) {
    const int lane = F.lane, tok = lane & 15, quad = lane >> 4, row = wu * 16 + tok; const bool has_prev = (row & (SEQ - 1)) != 0;
    unsigned char* ws = a.ws;
    const bf16* pr = (const bf16*)(ws + WS_PH) + (size_t)row * PP;
    const float* mu = a.in[I_MU] + (size_t)l * DSHIFT;
    const float* w0 = a.in[I_W0] + (size_t)l * DR; const float* a0 = a.in[I_A0] + (size_t)l * DR; const float* kk_ = a.in[I_KK] + (size_t)l * DR;
    const bf16* lf = (const bf16*)(ws + WS_LORA);
    bf16* E = (bf16*)(ws + WS_RWE) + (size_t)row * DR; bf16* A = (bf16*)(ws + WS_RWA) + (size_t)row * DR; bf16* KK = (bf16*)(ws + WS_RWK) + (size_t)row * DR; bf16* G = (bf16*)(ws + WS_RWG) + (size_t)row * DR;
    bf16x8 fw, fa, fg0, fg1;
    { float t[8]; shift8(pr, has_prev, C_XW + 8 * quad, mu, t);
#pragma unroll
      for (int j = 0; j < 8; ++j) t[j] = tanh_f(t[j]);
      fw = __builtin_bit_cast(bf16x8, pack8(t));
      shift8(pr, has_prev, C_XA + 8 * quad, mu, t); fa = __builtin_bit_cast(bf16x8, pack8(t));
      shift8(pr, has_prev, C_XG + 8 * quad, mu, t);
#pragma unroll
      for (int j = 0; j < 8; ++j) t[j] = sigmoid_f(t[j]);
      fg0 = __builtin_bit_cast(bf16x8, pack8(t));
      shift8(pr, has_prev, C_XG + 32 + 8 * quad, mu, t);
#pragma unroll
      for (int j = 0; j < 8; ++j) t[j] = sigmoid_f(t[j]);
      fg1 = __builtin_bit_cast(bf16x8, pack8(t)); }
    const f32x4 z4 = (f32x4){0.f, 0.f, 0.f, 0.f};
#pragma unroll 1
    for (int hh = 0; hh < NH; ++hh) {
        float kkv[4][4]; float ss = 0.f;
#pragma unroll
        for (int q4 = 0; q4 < 4; ++q4) {
            const int nt = 4 * hh + q4, c = 16 * nt + 4 * quad;
            const bf16x8 wf = *(const GAS bf16x8*)(lf + (size_t)(nt * 64 + lane) * 8), af = *(const GAS bf16x8*)(lf + (size_t)(1536 + nt * 64 + lane) * 8);
            const bf16x8 gf0 = *(const GAS bf16x8*)(lf + (size_t)(3072 + (nt * 2 + 0) * 64 + lane) * 8), gf1 = *(const GAS bf16x8*)(lf + (size_t)(3072 + (nt * 2 + 1) * 64 + lane) * 8);
            const f32x4 Dw = __builtin_amdgcn_mfma_f32_16x16x32_bf16(wf, fw, z4, 0, 0, 0);
            const f32x4 Da = __builtin_amdgcn_mfma_f32_16x16x32_bf16(af, fa, z4, 0, 0, 0);
            f32x4 Dg = __builtin_amdgcn_mfma_f32_16x16x32_bf16(gf0, fg0, z4, 0, 0, 0);
            Dg = __builtin_amdgcn_mfma_f32_16x16x32_bf16(gf1, fg1, Dg, 0, 0, 0);
            const f32x4 w04 = *(const GAS f32x4*)(w0 + c), a04 = *(const GAS f32x4*)(a0 + c), kk4 = *(const GAS f32x4*)(kk_ + c);
            float ks[4]; shift4(pr, has_prev, C_K + c, mu, ks);
            float e[4], av[4], gv[4];
#pragma unroll
            for (int j = 0; j < 4; ++j) { e[j] = 0.60653066f * sigmoid_f(w04[j] + Dw[j]); av[j] = sigmoid_f(a04[j] + Da[j]); gv[j] = Dg[j]; kkv[q4][j] = ks[j] * kk4[j]; ss += kkv[q4][j] * kkv[q4][j]; }
            v2u w; w.x = pk2(e[0], e[1]); w.y = pk2(e[2], e[3]); *(GAS v2u*)(E + c) = w;
            w.x = pk2(av[0], av[1]); w.y = pk2(av[2], av[3]); *(GAS v2u*)(A + c) = w;
            w.x = pk2(gv[0], gv[1]); w.y = pk2(gv[2], gv[3]); *(GAS v2u*)(G + c) = w;
        }
        ss += __shfl_xor(ss, 16); ss += __shfl_xor(ss, 32);
        const float inv = __builtin_amdgcn_rsqf(ss + 1e-12f);
#pragma unroll
        for (int q4 = 0; q4 < 4; ++q4) { const int c = 16 * (4 * hh + q4) + 4 * quad; v2u w; w.x = pk2(kkv[q4][0] * inv, kkv[q4][1] * inv); w.y = pk2(kkv[q4][2] * inv, kkv[q4][3] * inv); *(GAS v2u*)(KK + c) = w; }
    }
}
constexpr int CV_T = 32, CV_ROWS = CV_T + CW - 1;
DI void conv_unit(const Frame& F, const Args& a, int l, int cu) {
    const int b = cu / (SEQ / CV_T), t0 = (cu % (SEQ / CV_T)) * CV_T;
    unsigned char* ws = a.ws;
    const bf16* proj = (const bf16*)(ws + WS_PH); bf16* mix = (bf16*)(ws + WS_MIX);
    LAS float* z = (LAS float*)(F.lds + RING_OFF);
    LAS float* ob = z + CV_ROWS * DC;
    const float* cw = a.in[I_CW] + (size_t)l * CW * DC; const float* cb = a.in[I_CB] + (size_t)l * DC;
    const float* lw = a.in[I_CLW] + (size_t)l * DC; const float* lb = a.in[I_CLB] + (size_t)l * DC;
    { const int c8 = (F.tid & 31) * 8;
      for (int r = F.tid >> 5; r < CV_ROWS; r += 16) { const int t = t0 - (CW - 1) + r; float zz[8];
          if (t >= 0) { const bf16* pr = proj + (size_t)(b * SEQ + t) * PP; float u[8], g[8]; unpack8(*(const GAS v4u*)(pr + C_CU + c8), u); unpack8(*(const GAS v4u*)(pr + C_CG + c8), g);
#pragma unroll
              for (int j = 0; j < 8; ++j) zz[j] = u[j] * sigmoid_f(g[j]); }
          else {
#pragma unroll
              for (int j = 0; j < 8; ++j) zz[j] = 0.f; }
          *(LAS f32x4*)(z + r * DC + c8) = (f32x4){zz[0], zz[1], zz[2], zz[3]}; *(LAS f32x4*)(z + r * DC + c8 + 4) = (f32x4){zz[4], zz[5], zz[6], zz[7]}; } }
    __syncthreads();
    { const int ch = F.tid & 255, half = F.tid >> 8; float w[CW];
#pragma unroll
      for (int j = 0; j < CW; ++j) w[j] = cw[j * DC + ch];
      const float bias = cb[ch];
#pragma unroll 2
      for (int tt = 0; tt < 16; ++tt) { const int tl = 16 * half + tt; float acc = bias;
#pragma unroll
          for (int j = 0; j < CW; ++j) acc += z[(tl + j) * DC + ch] * w[j];
          ob[tl * DC + ch] = acc; } }
    __syncthreads();
#pragma unroll 1
    for (int i = 0; i < CV_T / NWAVES; ++i) { const int tl = F.wave * (CV_T / NWAVES) + i; const f32x4 v = *(const LAS f32x4*)(ob + tl * DC + 4 * F.lane);
        const float mean = wave_sum((v[0] + v[1]) + (v[2] + v[3])) * (1.0f / DC); const f32x4 d = v - mean;
        const float var = wave_sum((d[0] * d[0] + d[1] * d[1]) + (d[2] * d[2] + d[3] * d[3])) * (1.0f / DC); const float rstd = __builtin_amdgcn_rsqf(var + 1e-5f);
        const f32x4 lw4 = *(const GAS f32x4*)(lw + 4 * F.lane), lb4 = *(const GAS f32x4*)(lb + 4 * F.lane); float o[4];
#pragma unroll
        for (int j = 0; j < 4; ++j) { const float y = d[j] * rstd * lw4[j] + lb4[j]; o[j] = silu_x(y); }
        v2u w2; w2.x = pk2(o[0], o[1]); w2.y = pk2(o[2], o[3]);
        *(GAS v2u*)(mix + (size_t)(b * SEQ + t0 + tl) * DM + 768 + 4 * F.lane) = w2; }
    __syncthreads();
}
DI void phase4(const Frame& F, const Args& a, int l) {
    const int gw = F.bid * NWAVES + F.wave, NGW = F.G * NWAVES;
    for (int wu = gw; wu < M / 16; wu += NGW) rwkv_prep_unit(F, a, l, wu);
    for (int cu = F.bid; cu < BATCH * (SEQ / CV_T); cu += F.G) conv_unit(F, a, l, cu);
}

constexpr int SC_T = 32, SC_STEP = 336, SC_BUF = SC_T * SC_STEP, SC_NCH = SEQ / SC_T;
struct ScanConst { float mu_r, mu_k, mu_v, ka; };
DI void scan_produce(const Frame& F, const Args& a, int b, int h, int rg, int cc, LAS float* buf, const ScanConst& sc) {
    const int hw = F.wave - 4, lane = F.lane; unsigned char* ws = a.ws;
    const bf16* proj = (const bf16*)(ws + WS_PH); const bf16* E = (const bf16*)(ws + WS_RWE); const bf16* A = (const bf16*)(ws + WS_RWA); const bf16* KK = (const bf16*)(ws + WS_RWK);
#pragma unroll
    for (int tt = 0; tt < 8; ++tt) {
        const int step = 8 * hw + tt, t = SC_T * cc + step; const size_t row = (size_t)b * SEQ + t; const bool hp = t > 0;
        const bf16* pr = proj + row * PP; const int cj = 64 * h + lane;
        const float rc = bf1(pr[C_R + cj]), kc = bf1(pr[C_K + cj]);
        const float rp = hp ? bf1(pr[C_R + cj - PP]) : 0.f, kp = hp ? bf1(pr[C_K + cj - PP]) : 0.f;
        const float e = bf1(E[row * DR + cj]), av = bf1(A[row * DR + cj]), kk = bf1(KK[row * DR + cj]);
        float vs = 0.f;
        if (lane < 16) { const int cv = C_V + 64 * h + 16 * rg + lane; const float vc = bf1(pr[cv]); const float vp = hp ? bf1(pr[cv - PP]) : 0.f; vs = vc + (vp - vc) * sc.mu_v; }
        const float rs = rc + (rp - rc) * sc.mu_r, ks = kc + (kp - kc) * sc.mu_k;
        LAS float* st = buf + step * SC_STEP;
        st[lane] = -kk; st[64 + lane] = kk * av; st[128 + lane] = __expf(-e); st[192 + lane] = ks * (1.0f + (av - 1.0f) * sc.ka); st[256 + lane] = rs;
        if (lane < 16) st[320 + lane] = vs;
    }
}
DI void scan_writeout(const Frame& F, const Args& a, int b, int h, int rg, int cc, const LAS float* yb) {
    const int ht = (F.wave - 4) * 64 + F.lane, step = ht >> 3, pair = ht & 7;
    bf16* mix = (bf16*)(a.ws + WS_MIX);
    const float y0 = yb[step * 16 + 2 * pair], y1 = yb[step * 16 + 2 * pair + 1];
    *(GAS unsigned*)(mix + ((size_t)b * SEQ + SC_T * cc + step) * DM + 64 * h + 16 * rg + 2 * pair) = pk2(y0, y1);
}
DI void scan_item(const Frame& F, const Args& a, int l, int it) {
    const int b = it / 24, h = (it >> 2) % NH, rg = it & 3;
    LAS float* buf = (LAS float*)(F.lds + RING_OFF); LAS float* yb = buf + 2 * SC_BUF;
    const bool is_scan = F.wave < 4;
    const float* mu = a.in[I_MU] + (size_t)l * DSHIFT;
    ScanConst sc; sc.mu_r = mu[C_R + 64 * h + F.lane]; sc.mu_k = mu[C_K + 64 * h + F.lane]; sc.mu_v = mu[C_V + 64 * h + 16 * rg + (F.lane & 15)]; sc.ka = a.in[I_KA][(size_t)l * DR + 64 * h + F.lane];
    if (!is_scan) scan_produce(F, a, b, h, rg, 0, buf, sc);
    __syncthreads();
    f32x4 S = (f32x4){0.f, 0.f, 0.f, 0.f};
    const int ri = F.lane >> 4, cg = F.lane & 15, sw = F.wave;
#pragma unroll 1
    for (int cc = 0; cc < SC_NCH; ++cc) {
        if (is_scan) {
            const LAS float* s0 = buf + (cc & 1) * SC_BUF + 4 * cg; LAS float* y0 = yb + (cc & 1) * (SC_T * 16);
#pragma unroll 4
            for (int tt = 0; tt < SC_T; ++tt) {
                const LAS float* s = s0 + tt * SC_STEP;
                const f32x4 a4 = *(const LAS f32x4*)(s), b4 = *(const LAS f32x4*)(s + 64), w4 = *(const LAS f32x4*)(s + 128), k4 = *(const LAS f32x4*)(s + 192), r4 = *(const LAS f32x4*)(s + 256);
                const float v = buf[(cc & 1) * SC_BUF + tt * SC_STEP + 320 + 4 * sw + ri];
                const float sa = row16_sum((S[0] * a4[0] + S[1] * a4[1]) + (S[2] * a4[2] + S[3] * a4[3]));
                S = S * w4 + (sa * b4 + v * k4);
                const float y = row16_sum((S[0] * r4[0] + S[1] * r4[1]) + (S[2] * r4[2] + S[3] * r4[3]));
                if (cg == 0) y0[tt * 16 + 4 * sw + ri] = y;
            }
        } else {
            if (cc + 1 < SC_NCH) scan_produce(F, a, b, h, rg, cc + 1, buf + ((cc + 1) & 1) * SC_BUF, sc);
            if (cc > 0) scan_writeout(F, a, b, h, rg, cc - 1, yb + ((cc - 1) & 1) * (SC_T * 16));
        }
        __syncthreads();
    }
    if (!is_scan) scan_writeout(F, a, b, h, rg, SC_NCH - 1, yb + ((SC_NCH - 1) & 1) * (SC_T * 16));
    __syncthreads();
}

constexpr int AT_PITCH = 144, AT_K = 0, AT_V = 256 * AT_PITCH;
DI v4i16_t tr_read(const LAS unsigned char* p) { return __builtin_amdgcn_ds_read_tr16_b64_v4i16((LAS v4i16_t*)p); }
DI void attn_unit(const Frame& F, const Args& a, int l, int un, float shift2) {
    const int bh = un / 96, iu = un % 96, b = bh / NH, h = bh % NH, p = iu >> 5, r = iu & 31;
    const int d = (p == 0) ? 1 : (p == 1) ? 4 : 16, c = (p == 0) ? 0 : (p == 1) ? (r >> 3) : (r >> 1), n = (p == 0) ? r : (p == 1) ? (r & 7) : (r & 1);
    unsigned char* ws = a.ws; const bf16* proj = (const bf16*)(ws + WS_PH);
    const float* gq = a.in[I_QN] + (size_t)l * HD; const float* gk = a.in[I_KN] + (size_t)l * HD;
    const float slope = (h == 0) ? 0.25f : (h == 1) ? 0.0625f : (h == 2) ? 0.015625f : (h == 3) ? 0.00390625f : (h == 4) ? 0.5f : 0.125f;
    const float bco = -slope * (float)d * LOG2E;
    const int kb_lo = (n == 0) ? 128 : 0;
    LAS unsigned char* lds = F.lds + RING_OFF;
    {
        const int r8 = F.tid >> 3, ch = F.tid & 7;
        const f32x4 g0 = *(const GAS f32x4*)(gk + 8 * ch), g1 = *(const GAS f32x4*)(gk + 8 * ch + 4);
        for (int pass = kb_lo >> 6; pass < 4; ++pass) {
            const int kb = pass * 64 + r8, uk = 128 * (n - 1) + kb, t = c + d * uk;
            const bf16* src = proj + ((size_t)b * SEQ + t) * PP + 64 * h + 8 * ch;
            const v4u kv = *(const GAS v4u*)(src + C_AK), vv = *(const GAS v4u*)(src + C_AV);
            float kf[8]; unpack8(kv, kf); float ss = 0.f;
#pragma unroll
            for (int j = 0; j < 8; ++j) ss += kf[j] * kf[j];
            ss += __shfl_xor(ss, 1); ss += __shfl_xor(ss, 2); ss += __shfl_xor(ss, 4);
            const float sc = __builtin_amdgcn_rsqf(ss * (1.0f / HD) + 1e-6f);
#pragma unroll
            for (int j = 0; j < 8; ++j) kf[j] *= sc * (j < 4 ? g0[j] : g1[j - 4]);
            *(LAS v4u*)(lds + AT_K + kb * AT_PITCH + ch * 16) = pack8(kf);
            *(LAS v4u*)(lds + AT_V + kb * AT_PITCH + ch * 16) = vv;
        }
    }
    __syncthreads();
    const int w = F.wave, qi = F.lane & 15, quad = F.lane >> 4;
    const int uq = 128 * n + 16 * w + qi; const size_t qrow = (size_t)b * SEQ + c + d * uq;
    bf16x8 Qf0, Qf1;
    {   const bf16* qsrc = proj + qrow * PP + C_Q + 64 * h;
        float f0[8], f1[8]; unpack8(*(const GAS v4u*)(qsrc + 8 * quad), f0); unpack8(*(const GAS v4u*)(qsrc + 32 + 8 * quad), f1);
        float ss = 0.f;
#pragma unroll
        for (int j = 0; j < 8; ++j) ss += f0[j] * f0[j] + f1[j] * f1[j];
        ss += __shfl_xor(ss, 16); ss += __shfl_xor(ss, 32);
        const float sc = __builtin_amdgcn_rsqf(ss * (1.0f / HD) + 1e-6f) * (0.125f * LOG2E);
        const f32x4 a0 = *(const GAS f32x4*)(gq + 8 * quad), a1 = *(const GAS f32x4*)(gq + 8 * quad + 4), b0 = *(const GAS f32x4*)(gq + 32 + 8 * quad), b1 = *(const GAS f32x4*)(gq + 32 + 8 * quad + 4);
#pragma unroll
        for (int j = 0; j < 8; ++j) { f0[j] *= sc * (j < 4 ? a0[j] : a1[j - 4]); f1[j] *= sc * (j < 4 ? b0[j] : b1[j - 4]); }
        Qf0 = __builtin_bit_cast(bf16x8, pack8(f0)); Qf1 = __builtin_bit_cast(bf16x8, pack8(f1)); }
    f32x4 O[4];
#pragma unroll
    for (int dt = 0; dt < 4; ++dt) O[dt] = (f32x4){0.f, 0.f, 0.f, 0.f};
    float lsum = 0.f;
    int g_lo = (16 * w) >> 5; if (g_lo < (kb_lo >> 5)) g_lo = kb_lo >> 5;
    const int g_hi = (16 * w + 143) >> 5, qpos = 128 + 16 * w + qi;
    const f32x4 sinit = (f32x4){-shift2, -shift2, -shift2, -shift2};
#pragma unroll 1
    for (int g = g_lo; g <= g_hi; ++g) {
        float pk[8];
#pragma unroll
        for (int hf = 0; hf < 2; ++hf) {
            const int kb0 = 32 * g + 16 * hf;
            const LAS unsigned char* kaddr = lds + AT_K + (kb0 + qi) * AT_PITCH + quad * 16;
            const bf16x8 kf0 = *(const LAS bf16x8*)(kaddr), kf1 = *(const LAS bf16x8*)(kaddr + 64);
            f32x4 Sx = __builtin_amdgcn_mfma_f32_16x16x32_bf16(kf0, Qf0, sinit, 0, 0, 0);
            Sx = __builtin_amdgcn_mfma_f32_16x16x32_bf16(kf1, Qf1, Sx, 0, 0, 0);
#pragma unroll
            for (int j = 0; j < 4; ++j) { const int dist = qpos - (kb0 + 4 * quad + j);
                const float pv = (dist >= 0 && dist <= 128) ? __builtin_amdgcn_exp2f(Sx[j] + bco * (float)dist) : 0.f;
                lsum += pv; pk[4 * hf + j] = pv; }
        }
        const bf16x8 Pf = __builtin_bit_cast(bf16x8, pack8(pk));
        const LAS unsigned char* vaddr = lds + AT_V + (32 * g + 4 * quad + (qi >> 2)) * AT_PITCH + 8 * (qi & 3);
#pragma unroll
        for (int dt = 0; dt < 4; ++dt) {
            const v4i16_t lo = tr_read(vaddr + 32 * dt), hi = tr_read(vaddr + 32 * dt + 16 * AT_PITCH);
            const bf16x8 Vf = (bf16x8){lo[0], lo[1], lo[2], lo[3], hi[0], hi[1], hi[2], hi[3]};
            O[dt] = __builtin_amdgcn_mfma_f32_16x16x32_bf16(Vf, Pf, O[dt], 0, 0, 0);
        }
    }
    lsum += __shfl_xor(lsum, 16); lsum += __shfl_xor(lsum, 32);
    bf16* dst = (p == 0) ? (bf16*)(ws + WS_MIX) + qrow * DM + DR + 64 * h : (p == 1) ? (bf16*)(ws + WS_AP1) + qrow * DR + 64 * h : (bf16*)(ws + WS_AP2) + qrow * DR + 64 * h;
#pragma unroll
    for (int dt = 0; dt < 4; ++dt) { v2u wv; wv.x = pk2(O[dt][0], O[dt][1]); wv.y = pk2(O[dt][2], O[dt][3]); *(GAS v2u*)(dst + 16 * dt + 4 * quad) = wv; }
    if (quad == 0) ((float*)(ws + WS_ADEN))[((size_t)p * M + qrow) * 8 + h] = lsum;
    __syncthreads();
}
constexpr int N_SCAN_ITEMS = BATCH * NH * 4, N_ATT_UNITS = BATCH * NH * 96;
DI void phase5(const Frame& F, const Args& a, int l) {
    const int nsb = (F.G >= 256) ? N_SCAN_ITEMS : (F.G >= 4 ? (F.G * 3) / 4 : 0);
    if (F.bid < nsb) { for (int it = F.bid; it < N_SCAN_ITEMS; it += nsb) scan_item(F, a, l, it); }
    else {
        const float gqm = wave_max(fabsf(a.in[I_QN][(size_t)l * HD + F.lane])), gkm = wave_max(fabsf(a.in[I_KN][(size_t)l * HD + F.lane]));
        const float shift2 = 8.0f * gqm * gkm * LOG2E;
        for (int un = F.bid - nsb; un < N_ATT_UNITS; un += F.G - nsb) attn_unit(F, a, l, un, shift2);
        if (nsb == 0) for (int it = F.bid; it < N_SCAN_ITEMS; it += F.G) scan_item(F, a, l, it);
    }
}

DI float sum8(float v) { v += __shfl_xor(v, 1); v += __shfl_xor(v, 2); v += __shfl_xor(v, 4); return v; }
DI void ld8f(const float* p, float (&o)[8]) { const f32x4 a = *(const GAS f32x4*)p, b = *(const GAS f32x4*)(p + 4); o[0] = a[0]; o[1] = a[1]; o[2] = a[2]; o[3] = a[3]; o[4] = b[0]; o[5] = b[1]; o[6] = b[2]; o[7] = b[3]; }
DI void phase6(const Frame& F, const Args& a, int l) {
    const int gw = F.bid * NWAVES + F.wave, NGW = F.G * NWAVES; const int ln = F.lane < 48 ? F.lane : F.lane - 16; const bool act = F.lane < 48;
    const int c0 = 8 * ln, hh = ln >> 3; unsigned char* ws = a.ws;
    const float* mu = a.in[I_MU] + (size_t)l * DSHIFT;
    float ka[8], rk[8], lnw[8], lnb[8];
    ld8f(a.in[I_KA] + (size_t)l * DR + c0, ka); ld8f(a.in[I_RK] + (size_t)l * DR + c0, rk); ld8f(a.in[I_LNW] + (size_t)l * DR + c0, lnw); ld8f(a.in[I_LNB] + (size_t)l * DR + c0, lnb);
    const bf16* proj = (const bf16*)(ws + WS_PH); bf16* mix = (bf16*)(ws + WS_MIX);
    const bf16* A = (const bf16*)(ws + WS_RWA); const bf16* G = (const bf16*)(ws + WS_RWG);
    const bf16* P1 = (const bf16*)(ws + WS_AP1); const bf16* P2 = (const bf16*)(ws + WS_AP2); const float* DEN = (const float*)(ws + WS_ADEN);
#pragma unroll 1
    for (int row = gw; row < M; row += NGW) {
        const bool hp = (row & (SEQ - 1)) != 0; const bf16* pr = proj + (size_t)row * PP;
        float y[8], rs[8], ks[8], vs[8], av[8], gv[8];
        unpack8(*(const GAS v4u*)(mix + (size_t)row * DM + c0), y);
        shift8(pr, hp, C_R + c0, mu, rs); shift8(pr, hp, C_K + c0, mu, ks); shift8(pr, hp, C_V + c0, mu, vs);
        unpack8(*(const GAS v4u*)(A + (size_t)row * DR + c0), av); unpack8(*(const GAS v4u*)(G + (size_t)row * DR + c0), gv);
        float s = 0.f;
#pragma unroll
        for (int j = 0; j < 8; ++j) s += y[j];
        const float mean = sum8(s) * (1.0f / HD); float q = 0.f, rkv = 0.f;
#pragma unroll
        for (int j = 0; j < 8; ++j) { const float dd = y[j] - mean; q += dd * dd; const float kp = ks[j] * (1.0f + (av[j] - 1.0f) * ka[j]); rkv += rs[j] * kp * rk[j]; }
        const float rstd = __builtin_amdgcn_rsqf(sum8(q) * (1.0f / HD) + 64e-5f); rkv = sum8(rkv);
        float o[8];
#pragma unroll
        for (int j = 0; j < 8; ++j) o[j] = ((y[j] - mean) * rstd * lnw[j] + lnb[j] + rkv * vs[j]) * gv[j];
        if (act) *(GAS v4u*)(mix + (size_t)row * DM + c0) = pack8(o);
        float n0[8], n1[8], n2[8];
        unpack8(*(const GAS v4u*)(mix + (size_t)row * DM + DR + c0), n0); unpack8(*(const GAS v4u*)(P1 + (size_t)row * DR + c0), n1); unpack8(*(const GAS v4u*)(P2 + (size_t)row * DR + c0), n2);
        const float den = DEN[(size_t)row * 8 + hh] + DEN[((size_t)M + row) * 8 + hh] + DEN[((size_t)2 * M + row) * 8 + hh];
        const float rd = 1.0f / den;
#pragma unroll
        for (int j = 0; j < 8; ++j) o[j] = (n0[j] + n1[j] + n2[j]) * rd;
        if (act) *(GAS v4u*)(mix + (size_t)row * DM + DR + c0) = pack8(o);
    }
}

#ifndef MK_SINGLE
#define MK_SINGLE 1
#endif
__global__ void __launch_bounds__(NWAVES * 64, 2) mk_fwd(Args args) {
    extern __shared__ __attribute__((aligned(16))) unsigned char lds[];
    Frame F;
    F.lds = (LAS unsigned char*)lds;
    F.MISC = (volatile LAS unsigned*)(F.lds + MISC_OFF);
    F.tid = threadIdx.x; F.lane = F.tid & 63; F.wave = __builtin_amdgcn_readfirstlane(F.tid >> 6);
    F.G = gridDim.x; F.bid = blockIdx.x;
    unsigned char* ws = args.ws;
    F.ctl = (gu32*)(ws + WS_CTL);
    for (int u = F.tid; u < (LDS_BYTES - LDSCTL_OFF) / 4; u += NWAVES * 64) ((LAS unsigned*)(F.lds + LDSCTL_OFF))[u] = 0u;
    __syncthreads();
    XcdBarrier bar; bar.bar = (unsigned*)(F.ctl + CW_BAR); bar.x = 0; bar.st = nullptr;
    if (args.single) bar = xcd_barrier_post((unsigned*)(F.ctl + CW_BAR), F.MISC + 8);
#define GRID_BAR() do { if (args.single) xcd_barrier(bar); } while (0)
    const int lo = args.ph_lo, hi = args.ph_hi;
#ifndef PH_MASK
#define PH_MASK 0x3ff
#endif
#define IN(k) (((PH_MASK >> (k)) & 1) && lo <= (k) && (k) < hi)
    const pg8::bf16_t* XB = (const pg8::bf16_t*)(ws + WS_XB); pg8::bf16_t* PH = (pg8::bf16_t*)(ws + WS_PH); pg8::bf16_t* MIXB = (pg8::bf16_t*)(ws + WS_MIX); float* RSQ = (float*)(ws + WS_RSQ);
#pragma unroll 1
    for (int l = args.l_lo; l < args.l_hi; ++l) {
        { int t_ = threadIdx.x; asm volatile("" : "+v"(t_)); F.tid = t_; F.lane = t_ & 63; F.wave = __builtin_amdgcn_readfirstlane(t_ >> 6); }
        if (IN(0)) { phase0(F, args, l); GRID_BAR(); }
        if (IN(1)) {
            pg8::Gemm g{XB, (const pg8::bf16_t*)(ws + W_UP1), M, NUP, DM}; pg8::StaticOrder S; S.init(M, NUP, F.G, F.bid);
            pg8::EpiSwiglu E{PH, FF, RSQ};
            pg8::gemm_phase<pg8::EpiSwiglu, pg8::StaticOrder, true, true>(F.lds + RING_OFF, g, S, E);
            GRID_BAR(); }
        if (IN(2)) {
            pg8::Gemm g{PH, (const pg8::bf16_t*)(ws + W_DN1), M, DM, FF}; pg8::StaticOrder S; S.init(M, DM, F.G, F.bid);
            pg8::EpiResidual E{(l == 0) ? args.in[I_X] : args.out, args.out, (pg8::bf16_t*)(ws + WS_XB), RSQ, DM};
            pg8::gemm_phase<pg8::EpiResidual, pg8::StaticOrder, true, true>(F.lds + RING_OFF, g, S, E);
            GRID_BAR(); }
        if (IN(3)) {
            pg8::Gemm g{XB, (const pg8::bf16_t*)(ws + W_IN), M, PP, DM}; pg8::StaticOrder S; S.init(M, PP, F.G, F.bid);
            pg8::EpiProj E{PH, PP, RSQ};
            pg8::gemm_phase<pg8::EpiProj, pg8::StaticOrder, true, true>(F.lds + RING_OFF, g, S, E);
            GRID_BAR(); }
        if (IN(4)) { phase4(F, args, l); GRID_BAR(); }
        if (IN(5)) { phase5(F, args, l); GRID_BAR(); }
        if (IN(6)) { phase6(F, args, l); GRID_BAR(); }
        if (IN(7)) {
            pg8::Gemm g{MIXB, (const pg8::bf16_t*)(ws + W_OUT), M, DM, DM}; pg8::StaticOrder S; S.init(M, DM, F.G, F.bid);
            pg8::EpiResidual E{args.out, args.out, (pg8::bf16_t*)(ws + WS_XB), RSQ, DM};
            pg8::gemm_phase<pg8::EpiResidual, pg8::StaticOrder, true, true>(F.lds + RING_OFF, g, S, E);
            GRID_BAR(); }
        if (IN(8)) {
            pg8::Gemm g{XB, (const pg8::bf16_t*)(ws + W_UP2), M, NUP, DM}; pg8::StaticOrder S; S.init(M, NUP, F.G, F.bid);
            pg8::EpiSwiglu E{PH, FF, RSQ};
            pg8::gemm_phase<pg8::EpiSwiglu, pg8::StaticOrder, true, true>(F.lds + RING_OFF, g, S, E);
            GRID_BAR(); }
        if (IN(9)) {
            pg8::Gemm g{PH, (const pg8::bf16_t*)(ws + W_DN2), M, DM, FF}; pg8::StaticOrder S; S.init(M, DM, F.G, F.bid);
            pg8::EpiResidual E{args.out, args.out, (pg8::bf16_t*)(ws + WS_XB), RSQ, DM};
            pg8::gemm_phase<pg8::EpiResidual, pg8::StaticOrder, true, true>(F.lds + RING_OFF, g, S, E);
            GRID_BAR(); }
    }
#undef IN
#undef GRID_BAR
}

extern "C" void kernel_launch(void* const* d_in, const int* in_sizes, int n_in, void* d_out, int out_size, void* d_ws, size_t ws_size, hipStream_t stream) {
    static int grid = 0;
    if (grid == 0) {
        if (n_in != N_IN || in_sizes[0] != M * DM || out_size != M * DM || ws_size < WS_END) { fprintf(stderr, "kernel_launch: unexpected shapes (n_in %d, in0 %d, out %d, ws %zu < %zu); nothing launched\n", n_in, n_in > 0 ? in_sizes[0] : -1, out_size, ws_size, (size_t)WS_END); grid = -1; return; }
        int dev = 0, cus = 0, per_cu = 0;
        if (hipGetDevice(&dev) != hipSuccess || hipDeviceGetAttribute(&cus, hipDeviceAttributeMultiprocessorCount, dev) != hipSuccess) { grid = -1; return; }
        if (hipFuncSetAttribute((const void*)mk_fwd, hipFuncAttributeMaxDynamicSharedMemorySize, LDS_BYTES) != hipSuccess) { fprintf(stderr, "kernel_launch: hipFuncSetAttribute failed\n"); grid = -1; return; }
        if (hipOccupancyMaxActiveBlocksPerMultiprocessor(&per_cu, (const void*)mk_fwd, NWAVES * 64, LDS_BYTES) != hipSuccess || per_cu < 1) fprintf(stderr, "kernel_launch: occupancy query reports %d\n", per_cu);
        (void)hipGetLastError();
        grid = cus;
    }
    if (grid < 0) return;
    if (hipMemsetAsync((char*)d_ws + WS_CTL, 0, CTL_ZERO_BYTES, stream) != hipSuccess) return;
    Args a{};
    for (int i = 0; i < N_IN; ++i) a.in[i] = (const float*)d_in[i];
    a.out = (float*)d_out; a.ws = (unsigned char*)d_ws; a.pad = 0;
#if MK_SINGLE
    a.l_lo = 0; a.l_hi = DEPTH; a.ph_lo = 0; a.ph_hi = NPH; a.single = 1;
    hipLaunchKernelGGL(mk_fwd, dim3(grid), dim3(NWAVES * 64), LDS_BYTES, stream, a);
#else
    for (int l = 0; l < DEPTH; ++l)
        for (int ph = 0; ph < NPH; ++ph) { a.l_lo = l; a.l_hi = l + 1; a.ph_lo = ph; a.ph_hi = ph + 1; a.single = 0;
            hipLaunchKernelGGL(mk_fwd, dim3(grid), dim3(NWAVES * 64), LDS_BYTES, stream, a); }
#endif
}
```

```cpp
#include <hip/hip_runtime.h>
#include <cstdio>
#include <cstdint>
#define MK_SINGLE 1
namespace pg8 {
#define PG8_LAS __attribute__((address_space(3)))
typedef unsigned short bf16_t;
typedef short bf16x8 __attribute__((ext_vector_type(8)));
typedef float f32x4 __attribute__((ext_vector_type(4)));
typedef unsigned u32x4 __attribute__((ext_vector_type(4)));
constexpr int BM = 256, BK = 64, HALF = 128, HTB = HALF * BK * 2  , STAGE_BYTES = 8 * HTB, NXCD = 8, WGM = 8;

__host__ __device__ __forceinline__ int lds_byte(int r, int c) { const int st = (r >> 4) * 2 + (c >> 5), rr = r & 15, cc = c & 31, ob = rr * 64 + cc * 2; return st * 1024 + (ob ^ (((ob >> 9) & 1) << 5)); }
__host__ __device__ __forceinline__ void stage_rc(int b, int& R, int& C) { const int st = b / 1024, sb = b % 1024, swz = sb ^ (((sb >> 9) & 1) << 5); R = (st >> 1) * 16 + swz / 64; C = (st & 1) * 32 + (swz % 64) / 2; }
__host__ __device__ __forceinline__ int perm32(int rho) { const int n = rho >> 4, i = rho & 15; return 8 * (i >> 2) + 4 * n + (i & 3); }

struct Unit { int pm, pn; };
struct Gemm { const bf16_t* A; const bf16_t* Bt; int M, N, K; };

struct StaticOrder {
    int nM, nN, nwg, G, c;
    __host__ __device__ void init(int M, int N, int G_, int c_) { nM = M / BM; nN = N / BM; nwg = nM * nN; G = G_; c = c_; }
    __host__ __device__ bool next(int i, Unit& u) const {
        const long L = (long)i * G + c; if (L >= nwg) return false;
        int wgid = (int)L; { const int q = nwg / NXCD, r = nwg % NXCD, xcd = wgid % NXCD, off = wgid / NXCD; wgid = (xcd < r ? xcd * (q + 1) : r * (q + 1) + (xcd - r) * q) + off; }
        const int nig = WGM * nN, gid = wgid / nig, fm = gid * WGM, gsz = (nM % WGM == 0) ? WGM : ((nM - fm) < WGM ? (nM - fm) : WGM);
        u.pm = fm + ((wgid % nig) % gsz); u.pn = (wgid % nig) / gsz; return true;
    }
    __device__ __forceinline__ void a_ready(const Unit&) const {}
    __device__ __forceinline__ void done(const Unit&) const {}
};

__device__ __forceinline__ unsigned cvt_pk_bf16(float lo, float hi) { unsigned r; asm volatile("v_cvt_pk_bf16_f32 %0, %1, %2" : "=v"(r) : "v"(lo), "v"(hi)); return r; }
typedef float f32x2 __attribute__((ext_vector_type(2)));

__device__ __forceinline__ float row_scale(const float* rowsq, int row) {
    const f32x4* p = (const f32x4*)(rowsq + (size_t)row * 16);
    const f32x4 a = p[0], b = p[1], c = p[2], d = p[3];
    const float s = ((a[0] + a[1]) + (a[2] + a[3])) + ((b[0] + b[1]) + (b[2] + b[3])) + ((c[0] + c[1]) + (c[2] + c[3])) + ((d[0] + d[1]) + (d[2] + d[3]));
    return __builtin_amdgcn_rsqf(s * (1.0f / 1024.0f) + 1e-6f);
}
__device__ __forceinline__ void row_scales8(const float* rowsq, int row0, int fr, int fq, float (&s)[8]) {
    const int k0 = 2 * fq, k1 = 2 * fq + 1;
    const float sA = row_scale(rowsq, row0 + (k0 >> 2) * HALF + (k0 & 3) * 16), sB = row_scale(rowsq, row0 + (k1 >> 2) * HALF + (k1 & 3) * 16);
#pragma unroll
    for (int q = 0; q < 4; ++q) { s[2 * q] = __shfl(sA, fr + 16 * q); s[2 * q + 1] = __shfl(sB, fr + 16 * q); }
}
__device__ __forceinline__ void row_scales8_cached(const float* rowsq, PG8_LAS float* sc, bool fresh, int row0, int lrow0, int wc, int fr, int fq, float (&s)[8]) {
    if (fresh) {
        row_scales8(rowsq, row0, fr, fq, s);
        if (wc == 0 && fq == 0) {
#pragma unroll
            for (int k = 0; k < 8; ++k) sc[lrow0 + (k >> 2) * HALF + (k & 3) * 16] = s[k];
        }
    } else {
#pragma unroll
        for (int k = 0; k < 8; ++k) s[k] = sc[lrow0 + (k >> 2) * HALF + (k & 3) * 16];
    }
}
__device__ __forceinline__ float silu_f(float x) { return x * __builtin_amdgcn_rcpf(1.0f + __expf(-x)); }

struct EpiSwiglu {
    static constexpr bool PERM = true, AFTER_DRAIN = false;
    bf16_t* H; int ldh; const float* rowsq; PG8_LAS float* sc;
    __device__ __forceinline__ void operator()(const f32x4 (&acc)[2][2][4][2], const Unit& u, int wr, int wc, int fr, int fq, bool fresh) const {
        const int row0 = u.pm * BM + wr * 64 + fr, col0 = u.pn * HALF + wc * 32 + 8 * fq;
        float s8[8]; row_scales8_cached(rowsq, sc, fresh, row0, wr * 64 + fr, wc, fr, fq, s8);
#pragma unroll
        for (int ai = 0; ai < 2; ++ai)
#pragma unroll
            for (int m = 0; m < 4; ++m) {
                const int row = row0 + ai * HALF + m * 16; const float s = s8[4 * ai + m];
                const float c1 = -1.4426950408889634f * s, is2 = __builtin_amdgcn_rcpf(s * s);
                u32x4 w;
#pragma unroll
                for (int n = 0; n < 2; ++n) {
                    const f32x4 g = acc[ai][0][m][n], up = acc[ai][1][m][n];
                    const f32x4 t = g * c1;
                    f32x4 e; e[0] = __builtin_amdgcn_exp2f(t[0]); e[1] = __builtin_amdgcn_exp2f(t[1]); e[2] = __builtin_amdgcn_exp2f(t[2]); e[3] = __builtin_amdgcn_exp2f(t[3]);
                    const f32x4 d = e * is2 + is2;
                    f32x4 r; r[0] = __builtin_amdgcn_rcpf(d[0]); r[1] = __builtin_amdgcn_rcpf(d[1]); r[2] = __builtin_amdgcn_rcpf(d[2]); r[3] = __builtin_amdgcn_rcpf(d[3]);
                    const f32x4 h = (g * up) * r;
                    if (n == 0) { w.x = cvt_pk_bf16(h[0], h[1]); w.y = cvt_pk_bf16(h[2], h[3]); } else { w.z = cvt_pk_bf16(h[0], h[1]); w.w = cvt_pk_bf16(h[2], h[3]); }
                }
                *(u32x4*)(H + (size_t)row * ldh + col0) = w;
            }
    }
};
struct EpiProj {
    static constexpr bool PERM = true, AFTER_DRAIN = false;
    bf16_t* O; int ldc; const float* rowsq; PG8_LAS float* sc;
    __device__ __forceinline__ void operator()(const f32x4 (&acc)[2][2][4][2], const Unit& u, int wr, int wc, int fr, int fq, bool fresh) const {
        const int row0 = u.pm * BM + wr * 64 + fr, col0 = u.pn * BM + wc * 32 + 8 * fq;
        float s8[8]; row_scales8_cached(rowsq, sc, fresh, row0, wr * 64 + fr, wc, fr, fq, s8);
#pragma unroll
        for (int ai = 0; ai < 2; ++ai)
#pragma unroll
            for (int m = 0; m < 4; ++m) {
                const int row = row0 + ai * HALF + m * 16; const float s = s8[4 * ai + m];
#pragma unroll
                for (int bj = 0; bj < 2; ++bj) { if (u.pn * BM + bj * HALF >= 2944) continue;
                    const f32x4 v0 = acc[ai][bj][m][0] * s, v1 = acc[ai][bj][m][1] * s;
                    u32x4 w; w.x = cvt_pk_bf16(v0[0], v0[1]); w.y = cvt_pk_bf16(v0[2], v0[3]); w.z = cvt_pk_bf16(v1[0], v1[1]); w.w = cvt_pk_bf16(v1[2], v1[3]);
                    *(u32x4*)(O + (size_t)row * ldc + col0 + bj * HALF) = w; }
            }
    }
};
struct EpiResidual {
    static constexpr bool PERM = true, AFTER_DRAIN = false;
    float* out; bf16_t* xb; float* rowsq; int ldc;
    __device__ __forceinline__ void operator()(const f32x4 (&acc)[2][2][4][2], const Unit& u, int wr, int wc, int fr, int fq, bool) const {
        const int row0 = u.pm * BM + wr * 64 + fr, col0 = u.pn * BM + wc * 32 + 8 * fq;
        u32x4 b0[4][2], b1[4][2];
#pragma unroll
        for (int m = 0; m < 4; ++m)
#pragma unroll
            for (int bj = 0; bj < 2; ++bj) b0[m][bj] = *(const u32x4*)(xb + (size_t)(row0 + m * 16) * ldc + col0 + bj * HALF);
        asm volatile("" ::: "memory");
#pragma unroll
        for (int ai = 0; ai < 2; ++ai) {
#pragma unroll
            for (int m = 0; m < 4; ++m) {
                const int row = row0 + ai * HALF + m * 16; float ss = 0.f;
                if (ai == 0) {
#pragma unroll
                    for (int bj = 0; bj < 2; ++bj) b1[m][bj] = *(const u32x4*)(xb + (size_t)(row0 + HALF + m * 16) * ldc + col0 + bj * HALF);
                    asm volatile("" ::: "memory");
                }
#pragma unroll
                for (int bj = 0; bj < 2; ++bj) { const size_t off = (size_t)row * ldc + col0 + bj * HALF;
                    const u32x4 b = ai == 0 ? b0[m][bj] : b1[m][bj];
                    f32x4 v0, v1;
                    v0[0] = __builtin_bit_cast(float, b.x << 16) + acc[ai][bj][m][0][0]; v0[1] = __builtin_bit_cast(float, b.x & 0xffff0000u) + acc[ai][bj][m][0][1];
                    v0[2] = __builtin_bit_cast(float, b.y << 16) + acc[ai][bj][m][0][2]; v0[3] = __builtin_bit_cast(float, b.y & 0xffff0000u) + acc[ai][bj][m][0][3];
                    v1[0] = __builtin_bit_cast(float, b.z << 16) + acc[ai][bj][m][1][0]; v1[1] = __builtin_bit_cast(float, b.z & 0xffff0000u) + acc[ai][bj][m][1][1];
                    v1[2] = __builtin_bit_cast(float, b.w << 16) + acc[ai][bj][m][1][2]; v1[3] = __builtin_bit_cast(float, b.w & 0xffff0000u) + acc[ai][bj][m][1][3];
                    if (out) { *(f32x4*)(out + off) = v0; *(f32x4*)(out + off + 4) = v1; }
                    else {
                    const f32x4 q = v0 * v0 + v1 * v1;
                    ss += (q[0] + q[1]) + (q[2] + q[3]);
                    u32x4 w; w.x = cvt_pk_bf16(v0[0], v0[1]); w.y = cvt_pk_bf16(v0[2], v0[3]); w.z = cvt_pk_bf16(v1[0], v1[1]); w.w = cvt_pk_bf16(v1[2], v1[3]);
                    *(u32x4*)(xb + off) = w; } }
                if (!out) { ss += __shfl_xor(ss, 16); ss += __shfl_xor(ss, 32);
                    if (fq == 0) rowsq[(size_t)row * 16 + u.pn * 4 + wc] = ss; }
                asm volatile("" ::: "memory");
            }
        }
    }
};


template <class Epi, class Sched, bool ALIGN_EPI = false, bool SP2 = false>
__device__ __forceinline__ void gemm_phase(PG8_LAS unsigned char* lds, const Gemm g, const Sched& S, const Epi& E) {
    int tid_ = threadIdx.x; asm volatile("" : "+v"(tid_));
    const int tid = tid_, wid = __builtin_amdgcn_readfirstlane(tid >> 6), lane = tid & 63, wr = wid >> 2, wc = wid & 3, fr = lane & 15, fq = lane >> 4;
    const int K = g.K, nt = K / BK;
    unsigned voffA[2], voffB[2];
#pragma unroll
    for (int i = 0; i < 2; ++i) { int R, C; stage_rc(tid * 16 + i * 8192, R, C); const int Rb = Epi::PERM ? ((R & ~31) + perm32(R & 31)) : R;
        voffA[i] = (unsigned)(R * K + C) * 2u; voffB[i] = (unsigned)(Rb * K + C) * 2u; }
    const size_t kstep = (size_t)(BK * 2);
    const size_t hstep = (size_t)HALF * K * 2;
    const size_t tstep = 2 * hstep;
    const unsigned ldsw = (unsigned)wid * 1024u;
    const int aoff = lds_byte(wr * 64 + fr, fq * 8), boff = lds_byte(wc * 32 + fr, fq * 8);
#define PG8_SA(b, h) (((b) * 2 + (h)) * HTB)
#define PG8_SB(b, h) ((4 + (b) * 2 + (h)) * HTB)
#define PG8_STAGE(bufoff, gbase, voff) do { _Pragma("unroll") for (int _i = 0; _i < 2; ++_i) \
        __builtin_amdgcn_global_load_lds((const unsigned*)((const char*)(gbase) + (voff)[_i]), (PG8_LAS unsigned*)(lds + (bufoff) + ldsw + _i * 8192), 16, 0, 0); } while (0)
#define PG8_LDA(dst, b, h) do { _Pragma("unroll") for (int m = 0; m < 4; ++m) _Pragma("unroll") for (int k = 0; k < 2; ++k) dst[m][k] = *(const PG8_LAS bf16x8*)(lds + PG8_SA(b, h) + aoff + m * 2048 + k * 1024); } while (0)
#define PG8_LDB(dst, b, h) do { _Pragma("unroll") for (int n = 0; n < 2; ++n) _Pragma("unroll") for (int k = 0; k < 2; ++k) dst[n][k] = *(const PG8_LAS bf16x8*)(lds + PG8_SB(b, h) + boff + n * 2048 + k * 1024); } while (0)
#define PG8_MMA(ai, bj, At, Bt) do { __builtin_amdgcn_s_setprio(1); _Pragma("unroll") for (int m = 0; m < 4; ++m) _Pragma("unroll") for (int n = 0; n < 2; ++n) _Pragma("unroll") for (int k = 0; k < 2; ++k) \
        acc[ai][bj][m][n] = __builtin_amdgcn_mfma_f32_16x16x32_bf16(Bt[n][k], At[m][k], acc[ai][bj][m][n], 0, 0, 0); __builtin_amdgcn_s_setprio(0); } while (0)
#define PG8_WAIT_V(n) asm volatile("s_waitcnt vmcnt(" #n ")" ::: "memory")
#define PG8_WAIT_L(n) asm volatile("s_waitcnt lgkmcnt(" #n ")" ::: "memory")
#define PG8_BAR __builtin_amdgcn_s_barrier()
#define PG8_SCHED __builtin_amdgcn_sched_barrier(0)
    Unit cur, nxt; int ui = 0, ppm = -1;
    if (!S.next(0, cur)) return;
    f32x4 acc[2][2][4][2];
#pragma unroll
    for (int a = 0; a < 2; ++a)
#pragma unroll
        for (int b = 0; b < 2; ++b)
#pragma unroll
            for (int m = 0; m < 4; ++m)
#pragma unroll
                for (int n = 0; n < 2; ++n) acc[a][b][m][n] = (f32x4){0.f, 0.f, 0.f, 0.f};
    bf16x8 At[4][2], B0[2][2], B1[2][2];
    const char* cA = (const char*)g.A + (size_t)cur.pm * tstep; const char* cB = (const char*)g.Bt + (size_t)cur.pn * tstep;
    S.a_ready(cur);
    if constexpr (SP2) {
        PG8_STAGE(PG8_SB(0, 0), cB, voffB); PG8_STAGE(PG8_SB(0, 1), cB + hstep, voffB); PG8_STAGE(PG8_SA(0, 0), cA, voffA); PG8_STAGE(PG8_SA(0, 1), cA + hstep, voffA);
        if (wr == 1) PG8_BAR;
        PG8_WAIT_V(2); PG8_BAR;
        PG8_STAGE(PG8_SB(1, 0), cB + kstep, voffB); PG8_STAGE(PG8_SA(1, 0), cA + kstep, voffA); PG8_STAGE(PG8_SB(1, 1), cB + hstep + kstep, voffB);
        PG8_WAIT_V(6); PG8_BAR;
    } else {
        PG8_STAGE(PG8_SB(0, 0), cB, voffB); PG8_STAGE(PG8_SA(0, 0), cA, voffA); PG8_STAGE(PG8_SB(0, 1), cB + hstep, voffB); PG8_STAGE(PG8_SA(0, 1), cA + hstep, voffA);
        if (wr == 1) PG8_BAR;
        PG8_WAIT_V(4); PG8_BAR;
        PG8_STAGE(PG8_SB(1, 0), cB + kstep, voffB); PG8_STAGE(PG8_SA(1, 0), cA + kstep, voffA); PG8_STAGE(PG8_SB(1, 1), cB + hstep + kstep, voffB);
        PG8_WAIT_V(6); PG8_BAR;
    }
    for (;;) {
        const bool has_next = S.next(ui + 1, nxt);
        const char* nA = has_next ? (const char*)g.A + (size_t)nxt.pm * tstep : cA; const char* nB = has_next ? (const char*)g.Bt + (size_t)nxt.pn * tstep : cB;
        for (int t = 0; t < nt; t += 2) {
            const bool last = (t == nt - 2);
            const char* a1 = cA + (size_t)(t + 1) * kstep;
            const char* a2 = last ? nA : cA + (size_t)(t + 2) * kstep; const char* b2 = last ? nB : cB + (size_t)(t + 2) * kstep;
            const char* a3 = a2 + kstep; const char* b3 = b2 + kstep;
            if (last && has_next) S.a_ready(nxt);
            if constexpr (SP2) {
            PG8_LDB(B0, 0, 0); PG8_LDB(B1, 0, 1); PG8_SCHED; PG8_LDA(At, 0, 0); PG8_STAGE(PG8_SA(1, 1), a1 + hstep, voffA);
            PG8_WAIT_V(8); PG8_WAIT_L(0); PG8_BAR; PG8_MMA(0, 0, At, B0); PG8_MMA(0, 1, At, B1); PG8_BAR; PG8_SCHED;
            PG8_LDA(At, 0, 1); PG8_STAGE(PG8_SB(0, 0), b2, voffB); PG8_STAGE(PG8_SB(0, 1), b2 + hstep, voffB); PG8_STAGE(PG8_SA(0, 0), a2, voffA);
            PG8_WAIT_V(8); PG8_WAIT_L(0); PG8_BAR; PG8_MMA(1, 0, At, B0); PG8_MMA(1, 1, At, B1); PG8_BAR; PG8_SCHED;
            PG8_LDB(B0, 1, 0); PG8_LDB(B1, 1, 1); PG8_SCHED; PG8_LDA(At, 1, 0); PG8_STAGE(PG8_SA(0, 1), a2 + hstep, voffA);
            PG8_WAIT_V(8); PG8_WAIT_L(0); PG8_BAR; PG8_MMA(0, 0, At, B0); PG8_MMA(0, 1, At, B1); PG8_BAR; PG8_SCHED;
            PG8_LDA(At, 1, 1); PG8_STAGE(PG8_SB(1, 0), b3, voffB); PG8_STAGE(PG8_SB(1, 1), b3 + hstep, voffB); PG8_STAGE(PG8_SA(1, 0), a3, voffA);
            PG8_WAIT_V(8); PG8_WAIT_L(0); PG8_BAR; PG8_MMA(1, 0, At, B0); PG8_MMA(1, 1, At, B1); PG8_BAR; PG8_SCHED;
            } else {
            PG8_LDB(B0, 0, 0); PG8_SCHED; PG8_LDA(At, 0, 0); PG8_STAGE(PG8_SA(1, 1), a1 + hstep, voffA);
            PG8_WAIT_L(8); PG8_BAR; PG8_WAIT_L(0); PG8_MMA(0, 0, At, B0); PG8_BAR; PG8_SCHED;
            PG8_LDB(B1, 0, 1); PG8_STAGE(PG8_SB(0, 0), b2, voffB);
            PG8_BAR; PG8_WAIT_L(0); PG8_MMA(0, 1, At, B1); PG8_BAR;
            PG8_LDA(At, 0, 1); PG8_STAGE(PG8_SA(0, 0), a2, voffA);
            PG8_BAR; PG8_WAIT_L(0); PG8_MMA(1, 0, At, B0); PG8_BAR; PG8_SCHED;
            PG8_STAGE(PG8_SB(0, 1), b2 + hstep, voffB);
            PG8_WAIT_V(6); PG8_BAR; PG8_MMA(1, 1, At, B1); PG8_BAR;
            PG8_LDB(B0, 1, 0); PG8_SCHED; PG8_LDA(At, 1, 0); PG8_STAGE(PG8_SA(0, 1), a2 + hstep, voffA);
            PG8_WAIT_L(8); PG8_BAR; PG8_WAIT_L(0); PG8_MMA(0, 0, At, B0); PG8_BAR; PG8_SCHED;
            PG8_LDB(B1, 1, 1); PG8_STAGE(PG8_SB(1, 0), b3, voffB);
            PG8_BAR; PG8_WAIT_L(0); PG8_MMA(0, 1, At, B1); PG8_BAR;
            PG8_LDA(At, 1, 1); PG8_STAGE(PG8_SA(1, 0), a3, voffA);
            PG8_BAR; PG8_WAIT_L(0); PG8_MMA(1, 0, At, B0); PG8_BAR; PG8_SCHED;
            PG8_STAGE(PG8_SB(1, 1), b3 + hstep, voffB);
            PG8_WAIT_V(6); PG8_BAR; PG8_MMA(1, 1, At, B1); PG8_BAR;
            }
        }
        if constexpr (ALIGN_EPI) { if (wr == 0) PG8_BAR; }
        if constexpr (!Epi::AFTER_DRAIN) { E(acc, cur, wr, wc, fr, fq, cur.pm != ppm); ppm = cur.pm; S.done(cur); }
        if (!has_next) break;
#pragma unroll
        for (int a = 0; a < 2; ++a)
#pragma unroll
            for (int b = 0; b < 2; ++b)
#pragma unroll
                for (int m = 0; m < 4; ++m)
#pragma unroll
                    for (int n = 0; n < 2; ++n) acc[a][b][m][n] = (f32x4){0.f, 0.f, 0.f, 0.f};
        cur = nxt; cA = nA; cB = nB; ++ui;
        if constexpr (ALIGN_EPI) { if (wr == 1) PG8_BAR; }
    }
    PG8_WAIT_V(0);
    if constexpr (!ALIGN_EPI) { if (wr == 0) PG8_BAR; }
    PG8_BAR;
    if constexpr (Epi::AFTER_DRAIN) { E.fused(acc, cur, wr, wc, fr, fq, lds, wid, lane); S.done(cur); }
#undef PG8_SA
#undef PG8_SB
#undef PG8_STAGE
#undef PG8_LDA
#undef PG8_LDB
#undef PG8_MMA
#undef PG8_WAIT_V
#undef PG8_WAIT_L
#undef PG8_BAR
#undef PG8_SCHED
}
}

constexpr int NWAVES = 8;
constexpr int BATCH = 8, SEQ = 4096, DM = 1024, DEPTH = 4, M = BATCH * SEQ;
constexpr int FF = 2816, NUP = 2 * FF, DIN = 2944, PP = 3072;
constexpr int DR = 384, NH = 6, HD = 64, DSHIFT = 1280, DC = 256, CW = 31;
constexpr int C_R = 0, C_K = 384, C_V = 768, C_XW = 1152, C_XA = 1184, C_XG = 1216, C_Q = 1280, C_AK = 1664, C_AV = 2048, C_CU = 2432, C_CG = 2688;
constexpr int NPH = 10;
constexpr float LOG2E = 1.4426950408889634f;
enum { I_X = 0, I_NF1, I_WG1, I_WU1, I_WD1, I_NMIX, I_WIN, I_MU, I_W0, I_W2, I_A0, I_A2, I_G2, I_KK, I_KA, I_RK, I_LNW, I_LNB, I_QN, I_KN, I_CW, I_CB, I_CLW, I_CLB, I_WOUT, I_NF2, I_WG2, I_WU2, I_WD2, N_IN };

constexpr size_t MiB = 1u << 20;
constexpr size_t WS_CTL = 0, CTL_ZERO_BYTES = 32768;
constexpr size_t WS_LORA = 2 * MiB;
constexpr size_t WS_W = 4 * MiB;
constexpr size_t W_UP1 = WS_W, W_DN1 = W_UP1 + (size_t)NUP * DM * 2, W_IN = W_DN1 + (size_t)DM * FF * 2, W_OUT = W_IN + (size_t)PP * DM * 2,
                 W_UP2 = W_OUT + (size_t)DM * DM * 2, W_DN2 = W_UP2 + (size_t)NUP * DM * 2, W_END = W_DN2 + (size_t)DM * FF * 2;
constexpr size_t WS_XB = 48 * MiB;
constexpr size_t WS_PH = 112 * MiB;
constexpr size_t WS_MIX = 304 * MiB;
constexpr size_t WS_RSQ = 368 * MiB;
constexpr size_t WS_REC = 370 * MiB;
constexpr size_t WS_END = 512 * MiB;
constexpr size_t OUT_AP1 = 0, OUT_AP2 = 24 * MiB, OUT_ADEN = 48 * MiB, OUT_GT7 = 51 * MiB;
constexpr int OFF_P1T = 0, OFF_RT = 2048, OFF_BK = 4096  , OFF_VT = 8192, OFF_MM = 10240  , OFF_W2 = 11264, OFF_GAM = 11776, OFF_RK = 12032, RECB = 12096, GTB = 2048, SLOTB = 14336;
constexpr int NSC = SEQ / 16;
constexpr size_t OUT_YF = 54 * MiB;
static_assert(OUT_GT7 + 3 * MiB <= OUT_YF && OUT_YF + (size_t)BATCH * NH * NSC * 2048 <= (size_t)M * DM * 4, "scratch inside d_out");
static_assert(W_END <= WS_XB && WS_XB + (size_t)M * DM * 2 <= WS_PH && WS_PH + (size_t)M * PP * 2 <= WS_MIX && WS_MIX + (size_t)M * DM * 2 <= WS_RSQ && WS_RSQ + (size_t)M * 16 * 4 <= WS_REC && WS_REC + (size_t)BATCH * NH * NSC * RECB <= WS_END && WS_W + 7 * 3 * MiB <= W_OUT, "d_ws map");
constexpr int CW_BAR = 4096;

constexpr int RING_OFF = 0, RING_BYTES = 131072;
constexpr int LDSCTL_OFF = RING_BYTES, MISC_OFF = LDSCTL_OFF + 320;
constexpr int LDS_BYTES = 147456;

#define GAS __attribute__((address_space(1)))
#define LAS __attribute__((address_space(3)))
#define DI __device__ __forceinline__
typedef unsigned short bf16;
typedef unsigned v4u __attribute__((ext_vector_type(4)));
typedef unsigned v2u __attribute__((ext_vector_type(2)));
typedef float f32x4 __attribute__((ext_vector_type(4)));
typedef float f32x2 __attribute__((ext_vector_type(2)));
typedef short bf16x8 __attribute__((ext_vector_type(8)));
typedef short v4i16_t __attribute__((ext_vector_type(4)));
typedef GAS unsigned gu32;
#define RLX_AGENT __ATOMIC_RELAXED, __HIP_MEMORY_SCOPE_AGENT
#define LDS_WAIT() asm volatile("s_waitcnt lgkmcnt(0)" ::: "memory")
DI unsigned f2bf(float f) { unsigned u = __builtin_bit_cast(unsigned, f); return (u + 0x7fffu + ((u >> 16) & 1u)) >> 16; }
typedef float f32x2_t __attribute__((ext_vector_type(2))); typedef __bf16 bf16x2_t __attribute__((ext_vector_type(2)));
DI unsigned pk2(float lo, float hi) { f32x2_t v = {lo, hi}; bf16x2_t b = __builtin_convertvector(v, bf16x2_t); return __builtin_bit_cast(unsigned, b); }
DI float bflo(unsigned w) { return __builtin_bit_cast(float, w << 16); }
DI float bfhi(unsigned w) { return __builtin_bit_cast(float, w & 0xffff0000u); }
DI float bf1(bf16 h) { return __builtin_bit_cast(float, (unsigned)h << 16); }
DI void unpack8(const v4u w, float (&f)[8]) { f[0] = bflo(w.x); f[1] = bfhi(w.x); f[2] = bflo(w.y); f[3] = bfhi(w.y); f[4] = bflo(w.z); f[5] = bfhi(w.z); f[6] = bflo(w.w); f[7] = bfhi(w.w); }
DI v4u pack8(const float (&f)[8]) { v4u w; w.x = pk2(f[0], f[1]); w.y = pk2(f[2], f[3]); w.z = pk2(f[4], f[5]); w.w = pk2(f[6], f[7]); return w; }
DI void unpack4(const v2u w, float (&f)[4]) { f[0] = bflo(w.x); f[1] = bfhi(w.x); f[2] = bflo(w.y); f[3] = bfhi(w.y); }
DI float sigmoid_f(float x) { return __builtin_amdgcn_rcpf(1.0f + __expf(-x)); }
DI float silu_x(float x) { return x * sigmoid_f(x); }
DI float tanh_f(float x) { const float e = __expf(-2.0f * fabsf(x)); const float t = (1.0f - e) * __builtin_amdgcn_rcpf(1.0f + e); return x < 0.f ? -t : t; }

DI f32x4 mfma16k(v4i16_t a, v4i16_t b, f32x4 c, int, int, int) {
    const bf16x8 a8 = (bf16x8){a[0], a[1], a[2], a[3], 0, 0, 0, 0}, b8 = (bf16x8){b[0], b[1], b[2], b[3], 0, 0, 0, 0};
    return __builtin_amdgcn_mfma_f32_16x16x32_bf16(a8, b8, c, 0, 0, 0);
}
#define XB_TMO      128
#define XB_XCNT(j)  (256  + 64 * (j))
#define XB_XSUB(j)  (1280 + 64 * (j))
#define XB_XGEN(j)  (2304 + 64 * (j))
#define XB_TOP      3328
#define XB_TOPGEN   3392
#define XCD_BAR_WORDS 3456
#define XB_SPIN_CAP (1u << 18)

__device__ __forceinline__ unsigned xb_ld(unsigned* p)              { return __hip_atomic_load(p, __ATOMIC_RELAXED, __HIP_MEMORY_SCOPE_AGENT); }
__device__ __forceinline__ unsigned xb_add(unsigned* p, unsigned v) { return __hip_atomic_fetch_add(p, v, __ATOMIC_RELAXED, __HIP_MEMORY_SCOPE_AGENT); }
__device__ __forceinline__ unsigned xb_xcc_id() { return (unsigned)__builtin_amdgcn_s_getreg((3 << 11) | 20) & 0xFu; }
#define XB_SPIN(cond, bar) do { unsigned _sp = 0; while (cond) { __builtin_amdgcn_s_sleep(1); \
    if ((++_sp & 255u) == 0u) { if (xb_ld(&(bar)[XB_TMO])) break; if (_sp > XB_SPIN_CAP) { atomicAdd(&(bar)[XB_TMO], 1u); break; } } } } while (0)

struct XcdBarrier {
    unsigned* bar; unsigned x;
    volatile LAS unsigned* st;
};

__device__ __forceinline__ XcdBarrier xcd_barrier_post(unsigned* bar, volatile LAS unsigned* st) {
    XcdBarrier b; b.bar = bar; b.x = xb_xcc_id(); b.st = st;
    if (threadIdx.x == 0) (void)xb_add(&bar[XB_XCNT(b.x)], 1u);
    return b;
}
__device__ __forceinline__ void xcd_barrier_complete(unsigned* bar, unsigned x, unsigned& nloc, unsigned& nx) {
    const unsigned G = gridDim.x * gridDim.y * gridDim.z;
    unsigned sum, cnt, mine, sp = 0u;
    for (;;) {
        sum = 0u; cnt = 0u; mine = 0u;
#pragma unroll
        for (unsigned j = 0; j < 16; ++j) { const unsigned c = xb_ld(&bar[XB_XCNT(j)]); sum += c; cnt += (c > 0u) ? 1u : 0u; mine = (j == x) ? c : mine; }
        if (sum == G) break;
        __builtin_amdgcn_s_sleep(1);
        if ((++sp & 255u) == 0u) { if (xb_ld(&bar[XB_TMO])) break; if (sp > XB_SPIN_CAP) { atomicAdd(&bar[XB_TMO], 1u); break; } }
    }
    nloc = mine > 0u ? mine : 1u; nx = cnt > 0u ? cnt : 1u;
}

__device__ __forceinline__ void xcd_barrier(const XcdBarrier& b) {
    asm volatile("s_waitcnt vmcnt(0)" ::: "memory");
    __syncthreads();
    if (threadIdx.x == 0) {
        unsigned* bar = b.bar;
        __builtin_amdgcn_s_waitcnt(0);
        unsigned nloc = b.st[0], nx = b.st[1];
        if (nloc == 0u) { xcd_barrier_complete(bar, b.x, nloc, nx); b.st[0] = nloc; b.st[1] = nx; }
        const unsigned old = xb_add(&bar[XB_XSUB(b.x)], 1u);
        const unsigned gen = old / nloc;
        if (old + 1u == (gen + 1u) * nloc) {
            __builtin_amdgcn_fence(__ATOMIC_RELEASE, "agent");
            asm volatile("s_waitcnt vmcnt(0)" ::: "memory");
            const unsigned og = xb_add(&bar[XB_TOP], 1u);
            const unsigned tg = og / nx;
            if (og + 1u == (tg + 1u) * nx) xb_add(&bar[XB_TOPGEN], 1u);
            else XB_SPIN(xb_ld(&bar[XB_TOPGEN]) == tg, bar);
            __builtin_amdgcn_fence(__ATOMIC_ACQUIRE, "agent");
            xb_add(&bar[XB_XGEN(b.x)], 1u);
            asm volatile("s_waitcnt vmcnt(0)" ::: "memory");
        } else {
            XB_SPIN(xb_ld(&bar[XB_XGEN(b.x)]) == gen, bar);
            __builtin_amdgcn_fence(__ATOMIC_ACQUIRE, "agent");
            asm volatile("s_waitcnt vmcnt(0)" ::: "memory");
        }
    }
    __syncthreads();
}

struct Args { const float* in[N_IN]; float* out; unsigned char* ws; int l_lo, l_hi, ph_lo, ph_hi, single, pad; };
struct Frame {
    LAS unsigned char* lds;
    volatile LAS unsigned* MISC;
    gu32* ctl;
    int tid, lane, wave, G, bid;
};
DI float wave_sum(float v) {
#pragma unroll
    for (int o = 1; o < 64; o <<= 1) v += __shfl_xor(v, o);
    return v;
}
DI float wave_max(float v) {
#pragma unroll
    for (int o = 1; o < 64; o <<= 1) v = fmaxf(v, __shfl_xor(v, o));
    return v;
}
DI float row16_sum(float v) {
    v += __builtin_bit_cast(float, __builtin_amdgcn_mov_dpp(__builtin_bit_cast(int, v), 0xB1, 0xF, 0xF, true));
    v += __builtin_bit_cast(float, __builtin_amdgcn_mov_dpp(__builtin_bit_cast(int, v), 0x4E, 0xF, 0xF, true));
    v += __builtin_bit_cast(float, __builtin_amdgcn_mov_dpp(__builtin_bit_cast(int, v), 0x141, 0xF, 0xF, true));
    v += __builtin_bit_cast(float, __builtin_amdgcn_mov_dpp(__builtin_bit_cast(int, v), 0x140, 0xF, 0xF, true));
    return v;
}

DI void tr_item(const float* W, int K, int N, const float* ksc, float cs, bf16* WT, int drow0, LAS float* scr, int kb, int nb, int lane) {
    const int k0 = 64 * kb, n0 = 32 * nb;
    f32x4 v[8]; float sc[8];
#pragma unroll
    for (int i = 0; i < 8; ++i) { const int kk = 8 * i + (lane >> 3); v[i] = *(const GAS f32x4*)(W + (size_t)(k0 + kk) * N + n0 + 4 * (lane & 7)); sc[i] = ksc ? ksc[k0 + kk] * cs : cs; }
#pragma unroll
    for (int i = 0; i < 8; ++i) { const int kk = 8 * i + (lane >> 3); LAS float* d = scr + kk * 33 + 4 * (lane & 7); d[0] = v[i][0] * sc[i]; d[1] = v[i][1] * sc[i]; d[2] = v[i][2] * sc[i]; d[3] = v[i][3] * sc[i]; }
    LDS_WAIT(); asm volatile("" ::: "memory");
    const int c = lane & 7;
#pragma unroll
    for (int j = 0; j < 4; ++j) { const int n = (lane >> 3) + 8 * j; const LAS float* s = scr + (8 * c) * 33 + n;
        v4u o; o.x = pk2(s[0 * 33], s[1 * 33]); o.y = pk2(s[2 * 33], s[3 * 33]); o.z = pk2(s[4 * 33], s[5 * 33]); o.w = pk2(s[6 * 33], s[7 * 33]);
        *(GAS v4u*)(WT + (size_t)(drow0 + n) * K + k0 + 8 * c) = o; }
    LDS_WAIT(); asm volatile("" ::: "memory");
}
DI int glu_row(int nb, int up) { const int n0 = 32 * nb; return (n0 >> 7) * 256 + (n0 & 127) + up * 128; }
DI void phase0(const Frame& F, const Args& a, int l) {
    LAS float* scr = (LAS float*)(F.lds + RING_OFF + F.wave * 16384);
    const int gw = F.bid * NWAVES + F.wave, NGW = F.G * NWAVES;
    unsigned char* ws = a.ws;
    const float* nf1 = a.in[I_NF1] + (size_t)l * DM; const float* nmx = a.in[I_NMIX] + (size_t)l * DM; const float* nf2 = a.in[I_NF2] + (size_t)l * DM;
    const float* wg1 = a.in[I_WG1] + (size_t)l * DM * FF; const float* wu1 = a.in[I_WU1] + (size_t)l * DM * FF; const float* wd1 = a.in[I_WD1] + (size_t)l * FF * DM;
    const float* wg2 = a.in[I_WG2] + (size_t)l * DM * FF; const float* wu2 = a.in[I_WU2] + (size_t)l * DM * FF; const float* wd2 = a.in[I_WD2] + (size_t)l * FF * DM;
    const float* win = a.in[I_WIN] + (size_t)l * DM * DIN; const float* wout = a.in[I_WOUT] + (size_t)l * DM * DM;
    constexpr int I_GU = 16 * 88, I_DN = 44 * 32, I_IN = 16 * 92, I_OUT = 16 * 32, NITEMS = 4 * I_GU + 2 * I_DN + I_IN + I_OUT;
    for (int it = gw; it < NITEMS; it += NGW) {
        int r = it;
        if (r < I_GU) { tr_item(wg1, DM, FF, nf1, 1.f, (bf16*)(ws + W_UP1), glu_row(r % 88, 0), scr, r / 88, r % 88, F.lane); continue; } r -= I_GU;
        if (r < I_GU) { tr_item(wu1, DM, FF, nf1, 1.f, (bf16*)(ws + W_UP1), glu_row(r % 88, 1), scr, r / 88, r % 88, F.lane); continue; } r -= I_GU;
        if (r < I_DN) { tr_item(wd1, FF, DM, nullptr, 0.5f, (bf16*)(ws + W_DN1), 32 * (r % 32), scr, r / 32, r % 32, F.lane); continue; } r -= I_DN;
        if (r < I_IN) { tr_item(win, DM, DIN, nmx, 1.f, (bf16*)(ws + W_IN), 32 * (r % 92), scr, r / 92, r % 92, F.lane); continue; } r -= I_IN;
        if (r < I_OUT) { tr_item(wout, DM, DM, nullptr, 1.f, (bf16*)(ws + W_OUT), 32 * (r % 32), scr, r / 32, r % 32, F.lane); continue; } r -= I_OUT;
        if (r < I_GU) { tr_item(wg2, DM, FF, nf2, 1.f, (bf16*)(ws + W_UP2), glu_row(r % 88, 0), scr, r / 88, r % 88, F.lane); continue; } r -= I_GU;
        if (r < I_GU) { tr_item(wu2, DM, FF, nf2, 1.f, (bf16*)(ws + W_UP2), glu_row(r % 88, 1), scr, r / 88, r % 88, F.lane); continue; } r -= I_GU;
        tr_item(wd2, FF, DM, nullptr, 0.5f, (bf16*)(ws + W_DN2), 32 * (r % 32), scr, r / 32, r % 32, F.lane);
    }
    const int gt = F.bid * (NWAVES * 64) + F.tid, NGT = F.G * NWAVES * 64;
    for (int i = gt; i < (PP - DIN) * DM * 2 / 16; i += NGT) ((GAS v4u*)(ws + W_IN + (size_t)DIN * DM * 2))[i] = (v4u){0u, 0u, 0u, 0u};
    const float* w2 = a.in[I_W2] + (size_t)l * 32 * DR; const float* a2 = a.in[I_A2] + (size_t)l * 32 * DR; const float* g2 = a.in[I_G2] + (size_t)l * 64 * DR;
    bf16* lf = (bf16*)(ws + WS_LORA);
    for (int i = gt; i < 6144; i += NGT) {
        const float* src; int nt, ks, ln;
        if (i < 1536) { src = w2; nt = i >> 6; ks = 0; ln = i & 63; }
        else if (i < 3072) { src = a2; nt = (i - 1536) >> 6; ks = 0; ln = i & 63; }
        else { src = g2; const int ii = i - 3072; nt = ii >> 7; ks = (ii >> 6) & 1; ln = ii & 63; }
        const int n = ln & 15, q = ln >> 4; float f[8];
#pragma unroll
        for (int j = 0; j < 8; ++j) f[j] = src[(size_t)(32 * ks + 8 * q + j) * DR + 16 * nt + n];
        *(GAS v4u*)(lf + (size_t)i * 8) = pack8(f);
    }
    if (l == 0) {
        const float* x = a.in[I_X]; bf16* xb = (bf16*)(ws + WS_XB); float* rsq = (float*)(ws + WS_RSQ);
        for (int row = gw; row < M; row += NGW) {
            const GAS f32x4* xr = (const GAS f32x4*)(x + (size_t)row * DM) + F.lane; float ss = 0.f;
            GAS v2u* o8 = (GAS v2u*)(xb + (size_t)row * DM) + F.lane;
#pragma unroll
            for (int j = 0; j < 4; ++j) { const f32x4 v = xr[64 * j]; ss += (v[0] * v[0] + v[1] * v[1]) + (v[2] * v[2] + v[3] * v[3]); v2u w; w.x = pk2(v[0], v[1]); w.y = pk2(v[2], v[3]); o8[64 * j] = w; }
            ss = wave_sum(ss);
            if (F.lane < 16) rsq[(size_t)row * 16 + F.lane] = (F.lane == 0) ? ss : 0.f;
        }
    }
}

DI void shift8(const bf16* pr, bool has_prev, int col, const LAS float* mu, float (&o)[8]) {
    const v4u c = *(const GAS v4u*)(pr + col); v4u p = *(const GAS v4u*)(pr - (has_prev ? PP : 0) + col);
    if (!has_prev) p = (v4u){0u, 0u, 0u, 0u};
    float fc[8], fp[8]; unpack8(c, fc); unpack8(p, fp);
    const f32x4 m0 = *(const LAS f32x4*)(mu + col), m1 = *(const LAS f32x4*)(mu + col + 4);
#pragma unroll
    for (int j = 0; j < 8; ++j) { const float m = j < 4 ? m0[j] : m1[j - 4]; o[j] = fc[j] + (fp[j] - fc[j]) * m; }
}
DI void shift4(const bf16* pr, bool has_prev, int col, const LAS float* mu, float (&o)[4]) {
    const v2u c = *(const GAS v2u*)(pr + col); v2u p = *(const GAS v2u*)(pr - (has_prev ? PP : 0) + col);
    if (!has_prev) p = (v2u){0u, 0u};
    float fc[4], fp[4]; unpack4(c, fc); unpack4(p, fp);
    const f32x4 m0 = *(const LAS f32x4*)(mu + col);
#pragma unroll
    for (int j = 0; j < 4; ++j) o[j] = fc[j] + (fp[j] - fc[j]) * m0[j];
}
DI unsigned char* rec_ptr(unsigned char* ws, int b, int h, int sc) { return ws + WS_REC + (size_t)((b * NH + h) * NSC + sc) * RECB; }
DI unsigned char* gt_ptr(unsigned char* ws, unsigned char* outscr, int b, int h, int sc) { return (b < 7 ? ws + WS_W + (size_t)b * 3 * MiB : outscr + OUT_GT7) + (size_t)(h * NSC + sc) * GTB; }

#define ROW_SHR_ADD(x, n) x += __builtin_bit_cast(float, __builtin_amdgcn_update_dpp(0, __builtin_bit_cast(int, x), 0x110 + (n), 0xf, 0xf, true))
DI float row_prefix16(float x) { ROW_SHR_ADD(x, 1); ROW_SHR_ADD(x, 2); ROW_SHR_ADD(x, 4); ROW_SHR_ADD(x, 8); return x; }
DI v4i16_t pk4(float a, float b, float c, float d) { v2u w; w.x = pk2(a, b); w.y = pk2(c, d); return __builtin_bit_cast(v4i16_t, w); }
DI v4i16_t tr_read4(const LAS unsigned char* p) { return __builtin_amdgcn_ds_read_tr16_b64_v4i16((LAS v4i16_t*)p); }
constexpr int PL_PARAM = RING_OFF + 8 * 14336  ;
constexpr int PL_AT = 0, PL_BT = 2304, PL_KT = 4608, PL_V = 6912, PL_G = 9216, PL_MAB = 11520, PL_MKA = 12544, PL_BYTES = 14336, PL_PITCH = 144;
DI void prepass_unit(const Frame& F, const Args& a, int l, int wu) {
    const int lane = F.lane, tok = lane & 15, quad = lane >> 4, row = wu * 16 + tok; const bool has_prev = (row & (SEQ - 1)) != 0;
    const int b = (wu * 16) / SEQ, sc = ((wu * 16) & (SEQ - 1)) >> 4;
    unsigned char* ws = a.ws;
    LAS unsigned char* L = F.lds + RING_OFF + F.wave * PL_BYTES;
    const bf16* pr = (const bf16*)(ws + WS_PH) + (size_t)row * PP;
    const LAS float* mu = (const LAS float*)(F.lds + PL_PARAM); const LAS float* w0 = mu + DSHIFT; const LAS float* a0 = w0 + DR; const LAS float* kk_ = a0 + DR; const LAS float* ka_ = kk_ + DR; const LAS float* rk_ = ka_ + DR;
    const bf16* lf = (const bf16*)(ws + WS_LORA);
    bf16x8 fw, fa, fg0, fg1;
    { float t[8]; shift8(pr, has_prev, C_XW + 8 * quad, mu, t);
#pragma unroll
      for (int j = 0; j < 8; ++j) t[j] = tanh_f(t[j]);
      fw = __builtin_bit_cast(bf16x8, pack8(t));
      shift8(pr, has_prev, C_XA + 8 * quad, mu, t); fa = __builtin_bit_cast(bf16x8, pack8(t));
      shift8(pr, has_prev, C_XG + 8 * quad, mu, t);
#pragma unroll
      for (int j = 0; j < 8; ++j) t[j] = sigmoid_f(t[j]);
      fg0 = __builtin_bit_cast(bf16x8, pack8(t));
      shift8(pr, has_prev, C_XG + 32 + 8 * quad, mu, t);
#pragma unroll
      for (int j = 0; j < 8; ++j) t[j] = sigmoid_f(t[j]);
      fg1 = __builtin_bit_cast(bf16x8, pack8(t)); }
    const f32x4 z4 = (f32x4){0.f, 0.f, 0.f, 0.f};
#pragma unroll 1
    for (int hi_ = 0; hi_ < NH; ++hi_) {
        int hh = hi_; asm volatile("" : "+s"(hh));
        unsigned char* rec = rec_ptr(ws, b, hh, sc); unsigned char* gtp = gt_ptr(ws, (unsigned char*)a.out, b, hh, sc);
        f32x4 pDw[2], pDa[2], pDg[2];
#pragma unroll
        for (int q4 = 0; q4 < 2; ++q4) { const int nt = 4 * hh + q4;
            const bf16x8 wf = *(const GAS bf16x8*)(lf + (size_t)(nt * 64 + lane) * 8), af = *(const GAS bf16x8*)(lf + (size_t)(1536 + nt * 64 + lane) * 8);
            const bf16x8 gf0 = *(const GAS bf16x8*)(lf + (size_t)(3072 + (nt * 2 + 0) * 64 + lane) * 8), gf1 = *(const GAS bf16x8*)(lf + (size_t)(3072 + (nt * 2 + 1) * 64 + lane) * 8);
            pDw[q4] = __builtin_amdgcn_mfma_f32_16x16x32_bf16(wf, fw, z4, 0, 0, 0);
            pDa[q4] = __builtin_amdgcn_mfma_f32_16x16x32_bf16(af, fa, z4, 0, 0, 0);
            pDg[q4] = __builtin_amdgcn_mfma_f32_16x16x32_bf16(gf0, fg0, z4, 0, 0, 0);
            pDg[q4] = __builtin_amdgcn_mfma_f32_16x16x32_bf16(gf1, fg1, pDg[q4], 0, 0, 0); }
        float ss = 0.f, rkp = 0.f;
#pragma unroll
        for (int q4 = 0; q4 < 4; ++q4) { const int c = 16 * (4 * hh + q4) + 4 * quad; const f32x4 kk4 = *(const LAS f32x4*)(kk_ + c); float ks[4]; shift4(pr, has_prev, C_K + c, mu, ks);
#pragma unroll
            for (int j = 0; j < 4; ++j) { const float kr = ks[j] * kk4[j]; ss += kr * kr; } }
        ss += __shfl_xor(ss, 16); ss += __shfl_xor(ss, 32);
        const float inv = __builtin_amdgcn_rsqf(ss + 1e-12f);
        v4u At2[2], Bt2[2], Kt2[2], Rt2[2];
#pragma unroll
        for (int q4 = 0; q4 < 4; ++q4) {
            const int nt = 4 * hh + q4, c = 16 * nt + 4 * quad;
            f32x4 Dw, Da, Dg;
            if (q4 < 2) { Dw = pDw[q4 & 1]; Da = pDa[q4 & 1]; Dg = pDg[q4 & 1]; }
            else {
            const bf16x8 wf = *(const GAS bf16x8*)(lf + (size_t)(nt * 64 + lane) * 8), af = *(const GAS bf16x8*)(lf + (size_t)(1536 + nt * 64 + lane) * 8);
            const bf16x8 gf0 = *(const GAS bf16x8*)(lf + (size_t)(3072 + (nt * 2 + 0) * 64 + lane) * 8), gf1 = *(const GAS bf16x8*)(lf + (size_t)(3072 + (nt * 2 + 1) * 64 + lane) * 8);
            Dw = __builtin_amdgcn_mfma_f32_16x16x32_bf16(wf, fw, z4, 0, 0, 0);
            Da = __builtin_amdgcn_mfma_f32_16x16x32_bf16(af, fa, z4, 0, 0, 0);
            Dg = __builtin_amdgcn_mfma_f32_16x16x32_bf16(gf0, fg0, z4, 0, 0, 0);
            Dg = __builtin_amdgcn_mfma_f32_16x16x32_bf16(gf1, fg1, Dg, 0, 0, 0);
            }
            const f32x4 w04 = *(const LAS f32x4*)(w0 + c), a04 = *(const LAS f32x4*)(a0 + c), kk4 = *(const LAS f32x4*)(kk_ + c), ka4 = *(const LAS f32x4*)(ka_ + c), rk4 = *(const LAS f32x4*)(rk_ + c);
            float ks[4], rsh[4], vs[4]; shift4(pr, has_prev, C_K + c, mu, ks); shift4(pr, has_prev, C_R + c, mu, rsh); shift4(pr, has_prev, C_V + c, mu, vs);
            const int lo = tok * PL_PITCH + (16 * q4 + 4 * quad) * 2;
            *(LAS v4i16_t*)(L + PL_V + lo) = pk4(vs[0], vs[1], vs[2], vs[3]);
            *(LAS v4i16_t*)(L + PL_G + lo) = pk4(Dg[0], Dg[1], Dg[2], Dg[3]);
            float at[4], bt[4], kt[4], rt[4], gm[4];
#pragma unroll
            for (int j = 0; j < 4; ++j) { const float e = 0.60653066f * sigmoid_f(w04[j] + Dw[j]), agj = sigmoid_f(a04[j] + Da[j]), cum = row_prefix16(e);
                const float G = __expf(-cum), Gp = __expf(e - cum), Gi = __expf(cum), kkn = ks[j] * kk4[j] * inv, kpj = ks[j] * (1.0f + (agj - 1.0f) * ka4[j]);
                rkp += rsh[j] * kpj * rk4[j];
                at[j] = -kkn * Gp; bt[j] = kkn * agj * Gi; kt[j] = kpj * Gi; rt[j] = rsh[j] * G; gm[j] = G; }
            const unsigned a01 = pk2(at[0], at[1]), a23 = pk2(at[2], at[3]), b01 = pk2(bt[0], bt[1]), b23 = pk2(bt[2], bt[3]), k01 = pk2(kt[0], kt[1]), k23 = pk2(kt[2], kt[3]), r01 = pk2(rt[0], rt[1]), r23 = pk2(rt[2], rt[3]);
            if (q4 & 1) { At2[q4 >> 1].z = a01; At2[q4 >> 1].w = a23; Bt2[q4 >> 1].z = b01; Bt2[q4 >> 1].w = b23; Kt2[q4 >> 1].z = k01; Kt2[q4 >> 1].w = k23; Rt2[q4 >> 1].z = r01; Rt2[q4 >> 1].w = r23; }
            else { At2[q4 >> 1].x = a01; At2[q4 >> 1].y = a23; Bt2[q4 >> 1].x = b01; Bt2[q4 >> 1].y = b23; Kt2[q4 >> 1].x = k01; Kt2[q4 >> 1].y = k23; Rt2[q4 >> 1].x = r01; Rt2[q4 >> 1].y = r23; }
            *(LAS v2u*)(L + PL_AT + lo) = (v2u){a01, a23}; *(LAS v2u*)(L + PL_BT + lo) = (v2u){b01, b23}; *(LAS v2u*)(L + PL_KT + lo) = (v2u){k01, k23};
            if (tok == 15) *(GAS f32x4*)(rec + OFF_GAM + (16 * q4 + 4 * quad) * 4) = (f32x4){gm[0], gm[1], gm[2], gm[3]};
            if (q4 & 1) asm volatile("" ::: "memory");
        }
        rkp += __shfl_xor(rkp, 16); rkp += __shfl_xor(rkp, 32);
        f32x4 Mab = __builtin_amdgcn_mfma_f32_16x16x32_bf16(__builtin_bit_cast(bf16x8, Bt2[0]), __builtin_bit_cast(bf16x8, At2[0]), z4, 0, 0, 0);
        Mab = __builtin_amdgcn_mfma_f32_16x16x32_bf16(__builtin_bit_cast(bf16x8, Bt2[1]), __builtin_bit_cast(bf16x8, At2[1]), Mab, 0, 0, 0);
        f32x4 Mka = __builtin_amdgcn_mfma_f32_16x16x32_bf16(__builtin_bit_cast(bf16x8, Kt2[0]), __builtin_bit_cast(bf16x8, At2[0]), z4, 0, 0, 0);
        Mka = __builtin_amdgcn_mfma_f32_16x16x32_bf16(__builtin_bit_cast(bf16x8, Kt2[1]), __builtin_bit_cast(bf16x8, At2[1]), Mka, 0, 0, 0);
        f32x4 Mbr = __builtin_amdgcn_mfma_f32_16x16x32_bf16(__builtin_bit_cast(bf16x8, Bt2[0]), __builtin_bit_cast(bf16x8, Rt2[0]), z4, 0, 0, 0);
        Mbr = __builtin_amdgcn_mfma_f32_16x16x32_bf16(__builtin_bit_cast(bf16x8, Bt2[1]), __builtin_bit_cast(bf16x8, Rt2[1]), Mbr, 0, 0, 0);
        f32x4 Mkr = __builtin_amdgcn_mfma_f32_16x16x32_bf16(__builtin_bit_cast(bf16x8, Kt2[0]), __builtin_bit_cast(bf16x8, Rt2[0]), z4, 0, 0, 0);
        Mkr = __builtin_amdgcn_mfma_f32_16x16x32_bf16(__builtin_bit_cast(bf16x8, Kt2[1]), __builtin_bit_cast(bf16x8, Rt2[1]), Mkr, 0, 0, 0);
#pragma unroll
        for (int j = 0; j < 4; ++j) { const int s = 4 * quad + j; if (!(s < tok)) { Mab[j] = 0.f; Mka[j] = 0.f; } if (!(s <= tok)) { Mbr[j] = 0.f; Mkr[j] = 0.f; }
            *(LAS float*)(L + PL_MAB + (s * 16 + tok) * 4) = Mab[j]; *(LAS float*)(L + PL_MKA + (s * 16 + tok) * 4) = Mka[j]; }
        { v4u mm; mm.x = pk2(Mbr[0], Mbr[1]); mm.y = pk2(Mbr[2], Mbr[3]); mm.z = pk2(Mkr[0], Mkr[1]); mm.w = pk2(Mkr[2], Mkr[3]); *(GAS v4u*)(rec + OFF_MM + lane * 16) = mm; }
        *(GAS v4u*)(rec + OFF_RT + lane * 16) = Rt2[0]; *(GAS v4u*)(rec + OFF_RT + (64 + lane) * 16) = Rt2[1];
        if (quad == 0) *(GAS float*)(rec + OFF_RK + tok * 4) = rkp;
        LDS_WAIT(); asm volatile("" ::: "memory");
        float Tc[16]; f32x4 mrow[2][4];
        Tc[15] = (tok == 15) ? 1.0f : 0.0f;
        mrow[0][3] = *(const LAS f32x4*)(L + PL_MAB + (14 * 16 + 12) * 4);
        asm volatile("" ::: "memory");
#pragma unroll
        for (int s = 14; s >= 0; --s) { float acc = (s == tok) ? 1.0f : 0.0f;
            if (s > 0) {
#pragma unroll
                for (int q = s >> 2; q < 4; ++q) mrow[(s + 1) & 1][q] = *(const LAS f32x4*)(L + PL_MAB + ((s - 1) * 16 + 4 * q) * 4);
            }
            asm volatile("" ::: "memory");
#pragma unroll
            for (int q = (s + 1) >> 2; q < 4; ++q) { const f32x4 m = mrow[s & 1][q];
#pragma unroll
                for (int j = 0; j < 4; ++j) if (4 * q + j > s) acc += m[j] * Tc[4 * q + j]; }
            Tc[s] = acc; }
        float tf[4];
#pragma unroll
        for (int j = 0; j < 4; ++j) tf[j] = (quad == 0) ? Tc[j] : (quad == 1) ? Tc[4 + j] : (quad == 2) ? Tc[8 + j] : Tc[12 + j];
        const v4i16_t Tf = pk4(tf[0], tf[1], tf[2], tf[3]);
        const int tro = (4 * quad + (tok >> 2)) * PL_PITCH + 8 * (tok & 3);
        v4u P1[2];
#pragma unroll
        for (int jt = 0; jt < 4; ++jt) {
            const v4i16_t Af = tr_read4(L + PL_AT + tro + 32 * jt);
            const f32x4 D = mfma16k(Af, Tf, z4, 0, 0, 0);
            const unsigned p01 = pk2(D[0], D[1]), p23 = pk2(D[2], D[3]);
            if (jt & 1) { P1[jt >> 1].z = p01; P1[jt >> 1].w = p23; } else { P1[jt >> 1].x = p01; P1[jt >> 1].y = p23; }
            { const v4i16_t bt = tr_read4(L + PL_BT + tro + 32 * jt), kt = tr_read4(L + PL_KT + tro + 32 * jt);
              *(GAS bf16x8*)(rec + OFF_BK + (jt * 64 + lane) * 16) = (bf16x8){bt[0], bt[1], bt[2], bt[3], kt[0], kt[1], kt[2], kt[3]}; }
            *(GAS v4i16_t*)(rec + OFF_VT + (jt * 64 + lane) * 8) = tr_read4(L + PL_V + tro + 32 * jt);
            *(GAS v4i16_t*)(gtp + (jt * 64 + lane) * 8) = tr_read4(L + PL_G + tro + 32 * jt);
        }
        *(GAS v4u*)(rec + OFF_P1T + lane * 16) = P1[0]; *(GAS v4u*)(rec + OFF_P1T + (64 + lane) * 16) = P1[1];
        { const f32x4 mk = *(const LAS f32x4*)(L + PL_MKA + (tok * 16 + 4 * quad) * 4);
          const f32x4 W2 = mfma16k(pk4(mk[0], mk[1], mk[2], mk[3]), Tf, z4, 0, 0, 0);
          *(GAS v4i16_t*)(rec + OFF_W2 + lane * 8) = pk4(W2[0], W2[1], W2[2], W2[3]); }
        LDS_WAIT(); asm volatile("" ::: "memory");
    }
}
constexpr int CV_T = 32, CV_ROWS = CV_T + CW - 1;
DI void conv_unit(const Frame& F, const Args& a, int l, int cu) {
    const int b = cu / (SEQ / CV_T), t0 = (cu % (SEQ / CV_T)) * CV_T;
    unsigned char* ws = a.ws;
    const bf16* proj = (const bf16*)(ws + WS_PH); bf16* mix = (bf16*)(ws + WS_MIX);
    LAS float* z = (LAS float*)(F.lds + RING_OFF);
    LAS float* ob = z + CV_ROWS * DC;
    const LAS float* cw = ob + CV_T * DC; const LAS float* cb = cw + CW * DC;
    const float* lw = a.in[I_CLW] + (size_t)l * DC; const float* lb = a.in[I_CLB] + (size_t)l * DC;
    { const int c8 = (F.tid & 31) * 8;
      for (int r = F.tid >> 5; r < CV_ROWS; r += 16) { const int t = t0 - (CW - 1) + r; float zz[8];
          if (t >= 0) { const bf16* pr = proj + (size_t)(b * SEQ + t) * PP; float u[8], g[8]; unpack8(*(const GAS v4u*)(pr + C_CU + c8), u); unpack8(*(const GAS v4u*)(pr + C_CG + c8), g);
#pragma unroll
              for (int j = 0; j < 8; ++j) zz[j] = u[j] * sigmoid_f(g[j]); }
          else {
#pragma unroll
              for (int j = 0; j < 8; ++j) zz[j] = 0.f; }
          *(LAS f32x4*)(z + r * DC + c8) = (f32x4){zz[0], zz[1], zz[2], zz[3]}; *(LAS f32x4*)(z + r * DC + c8 + 4) = (f32x4){zz[4], zz[5], zz[6], zz[7]}; } }
    __syncthreads();
    { const int ch = F.tid & 255, half = F.tid >> 8; float w[CW];
#pragma unroll
      for (int j = 0; j < CW; ++j) w[j] = cw[j * DC + ch];
      const float bias = cb[ch];
#pragma unroll 2
      for (int tt = 0; tt < 16; ++tt) { const int tl = 16 * half + tt; float acc = bias;
#pragma unroll
          for (int j = 0; j < CW; ++j) acc += z[(tl + j) * DC + ch] * w[j];
          ob[tl * DC + ch] = acc; } }
    __syncthreads();
#pragma unroll 1
    for (int i = 0; i < CV_T / NWAVES; ++i) { const int tl = F.wave * (CV_T / NWAVES) + i; const f32x4 v = *(const LAS f32x4*)(ob + tl * DC + 4 * F.lane);
        const float mean = wave_sum((v[0] + v[1]) + (v[2] + v[3])) * (1.0f / DC); const f32x4 d = v - mean;
        const float var = wave_sum((d[0] * d[0] + d[1] * d[1]) + (d[2] * d[2] + d[3] * d[3])) * (1.0f / DC); const float rstd = __builtin_amdgcn_rsqf(var + 1e-5f);
        const f32x4 lw4 = *(const GAS f32x4*)(lw + 4 * F.lane), lb4 = *(const GAS f32x4*)(lb + 4 * F.lane); float o[4];
#pragma unroll
        for (int j = 0; j < 4; ++j) { const float y = d[j] * rstd * lw4[j] + lb4[j]; o[j] = silu_x(y); }
        v2u w2; w2.x = pk2(o[0], o[1]); w2.y = pk2(o[2], o[3]);
        *(GAS v2u*)(mix + (size_t)(b * SEQ + t0 + tl) * DM + 768 + 4 * F.lane) = w2; }
    __syncthreads();
}
DI void conv_stage_taps(const Frame& F, const Args& a, int l) {
    LAS float* cw = (LAS float*)(F.lds + RING_OFF) + (CV_ROWS + CV_T) * DC;
    for (int i = F.tid; i < (CW + 1) * DC; i += NWAVES * 64) cw[i] = (i < CW * DC) ? a.in[I_CW][(size_t)l * CW * DC + i] : a.in[I_CB][(size_t)l * DC + i - CW * DC];
    __syncthreads();
}
DI void phase4(const Frame& F, const Args& a, int l) {
    const int gw = F.bid * NWAVES + F.wave, NGW = F.G * NWAVES;
#ifndef PREP_REP
#define PREP_REP 1
#endif
#ifndef CONV_REP
#define CONV_REP 1
#endif
    { LAS float* pt = (LAS float*)(F.lds + PL_PARAM);
      for (int i = F.tid; i < DSHIFT + 5 * DR; i += NWAVES * 64) { const int j = i - DSHIFT, k = j / DR, c = j - k * DR;
          pt[i] = (i < DSHIFT) ? a.in[I_MU][(size_t)l * DSHIFT + i] : a.in[(k == 0) ? I_W0 : (k == 1) ? I_A0 : (k == 2) ? I_KK : (k == 3) ? I_KA : I_RK][(size_t)l * DR + c]; }
      __syncthreads(); }
    for (int wu = gw; wu < PREP_REP * (M / 16); wu += NGW) prepass_unit(F, a, l, wu % (M / 16));
    __syncthreads();
}

DI void ld8f(const float* p, float (&o)[8]) { const f32x4 a = *(const GAS f32x4*)p, b = *(const GAS f32x4*)(p + 4); o[0] = a[0]; o[1] = a[1]; o[2] = a[2]; o[3] = a[3]; o[4] = b[0]; o[5] = b[1]; o[6] = b[2]; o[7] = b[3]; }
constexpr int SC_NB = 4, SC_PIECES = (RECB + GTB) / 16, SC_REC_PIECES = RECB / 16;
#define SC_BARRIER() asm volatile("s_waitcnt lgkmcnt(0)\n\ts_barrier" ::: "memory")
struct ScanFrags { bf16x8 P0, P1, R0, R1, MM; v4i16_t Vf, W2; };
DI void scan_frags(ScanFrags& f, const LAS unsigned char* slot, int rg, int lane) {
    f.P0 = *(const LAS bf16x8*)(slot + OFF_P1T + lane * 16); f.P1 = *(const LAS bf16x8*)(slot + OFF_P1T + (64 + lane) * 16);
    f.R0 = *(const LAS bf16x8*)(slot + OFF_RT + lane * 16); f.R1 = *(const LAS bf16x8*)(slot + OFF_RT + (64 + lane) * 16);
    f.Vf = *(const LAS v4i16_t*)(slot + OFF_VT + (rg * 64 + lane) * 8);
    f.MM = *(const LAS bf16x8*)(slot + OFF_MM + lane * 16); f.W2 = *(const LAS v4i16_t*)(slot + OFF_W2 + lane * 8);
}
DI void scan_bh(const Frame& F, const Args& a, int l, int bh) {
    const int b = bh / NH, h = bh % NH, lane = F.lane, il = lane & 15, quad = lane >> 4, rg = F.wave & 3;
    unsigned char* ws = a.ws;
    LAS unsigned char* ring = F.lds + RING_OFF;
    const bool is_scan = F.wave < 4;
    const unsigned char* rec0 = rec_ptr(ws, b, h, 0);
    const int ltid = rg * 64 + lane;
    constexpr int NB2 = 8, SL2 = 12288, SCP = OFF_RK / 16;
    v4u lr[12];
#define SC_LOAD2(scx, o_) do { _Pragma("unroll") for (int i_ = 0; i_ < 3; ++i_) { const int p_ = ltid + 256 * i_; if (p_ < SCP) lr[(o_) + i_] = *(const GAS v4u*)(rec0 + (size_t)(scx) * RECB + p_ * 16); } } while (0)
#define SC_STORE2(scx, o_) do { _Pragma("unroll") for (int i_ = 0; i_ < 3; ++i_) { const int p_ = ltid + 256 * i_; if (p_ < SCP) *(LAS v4u*)(ring + ((scx) & (NB2 - 1)) * SL2 + p_ * 16) = lr[(o_) + i_]; } } while (0)
    if (!is_scan) { SC_LOAD2(0, 0); SC_LOAD2(1, 3); SC_LOAD2(2, 6); SC_LOAD2(3, 9); SC_STORE2(0, 0); SC_STORE2(1, 3); SC_STORE2(2, 6); SC_STORE2(3, 9); SC_LOAD2(4, 0); SC_LOAD2(5, 3); SC_LOAD2(6, 6); SC_LOAD2(7, 9); }
    SC_BARRIER();
    f32x4 S[4];
#pragma unroll
    for (int jt = 0; jt < 4; ++jt) S[jt] = (f32x4){0.f, 0.f, 0.f, 0.f};
    unsigned char* yfp = (unsigned char*)a.out + OUT_YF + ((size_t)(b * NH + h) * NSC * 4 + rg) * 512 + lane * 8;
    const f32x4 z4 = (f32x4){0.f, 0.f, 0.f, 0.f};
    ScanFrags fn;
#pragma unroll 1
    for (int it = 0; it < NSC / 4; ++it) {
        if (is_scan) {
#pragma unroll
            for (int s2 = 0; s2 < 4; ++s2) {
                const int sc = 4 * it + s2;
                const LAS unsigned char* slot = ring + (sc & (NB2 - 1)) * SL2;
                if (s2 == 0) scan_frags(fn, slot, rg, lane);
                const ScanFrags f = fn;
                if (s2 < 3) scan_frags(fn, ring + ((sc + 1) & (NB2 - 1)) * SL2, rg, lane);
                v4u sb0, sb1;
                sb0.x = pk2(S[0][0], S[0][1]); sb0.y = pk2(S[0][2], S[0][3]); sb0.z = pk2(S[1][0], S[1][1]); sb0.w = pk2(S[1][2], S[1][3]);
                sb1.x = pk2(S[2][0], S[2][1]); sb1.y = pk2(S[2][2], S[2][3]); sb1.z = pk2(S[3][0], S[3][1]); sb1.w = pk2(S[3][2], S[3][3]);
                const bf16x8 Sb0 = __builtin_bit_cast(bf16x8, sb0), Sb1 = __builtin_bit_cast(bf16x8, sb1);
                f32x4 U = mfma16k(f.W2, f.Vf, z4, 0, 0, 0);
                U = __builtin_amdgcn_mfma_f32_16x16x32_bf16(f.P0, Sb0, U, 0, 0, 0);
                U = __builtin_amdgcn_mfma_f32_16x16x32_bf16(f.P1, Sb1, U, 0, 0, 0);
                f32x4 Y = __builtin_amdgcn_mfma_f32_16x16x32_bf16(f.R0, Sb0, z4, 0, 0, 0);
                Y = __builtin_amdgcn_mfma_f32_16x16x32_bf16(f.R1, Sb1, Y, 0, 0, 0);
                const v4i16_t Ub = pk4(U[0], U[1], U[2], U[3]);
                const bf16x8 UV = (bf16x8){Ub[0], Ub[1], Ub[2], Ub[3], f.Vf[0], f.Vf[1], f.Vf[2], f.Vf[3]};
#pragma unroll
                for (int jt = 0; jt < 4; ++jt) {
                    const bf16x8 BK = *(const LAS bf16x8*)(slot + OFF_BK + (jt * 64 + lane) * 16);
                    const f32x4 gm = *(const LAS f32x4*)(slot + OFF_GAM + (16 * jt + 4 * quad) * 4);
                    S[jt] = __builtin_amdgcn_mfma_f32_16x16x32_bf16(BK, UV, S[jt], 0, 0, 0);
                    S[jt] = S[jt] * gm;
                }
                Y = __builtin_amdgcn_mfma_f32_16x16x32_bf16(f.MM, UV, Y, 0, 0, 0);
                { v2u yw; yw.x = pk2(Y[0], Y[1]); yw.y = pk2(Y[2], Y[3]); *(GAS v2u*)(yfp + (size_t)sc * 2048) = yw; }
            }
        } else {
            if (4 * it + 4 < NSC) { SC_STORE2(4 * it + 4, 0); SC_STORE2(4 * it + 5, 3); SC_STORE2(4 * it + 6, 6); SC_STORE2(4 * it + 7, 9); }
            if (4 * it + 8 < NSC) { SC_LOAD2(4 * it + 8, 0); SC_LOAD2(4 * it + 9, 3); SC_LOAD2(4 * it + 10, 6); SC_LOAD2(4 * it + 11, 9); }
        }
        SC_BARRIER();
    }
    SC_BARRIER();
#undef SC_LOAD2
#undef SC_STORE2
}

constexpr int AT_PITCH = 144, AT_KEYS = 384, AT_K = 0, AT_V = AT_KEYS * AT_PITCH, AT_PASSES = AT_KEYS / 64, AT_UPB = 48  ;
constexpr int AT_GAIN = LDSCTL_OFF + 2048;
#define ATT_DPP_ADD(x, ctrl) x += __builtin_bit_cast(float, __builtin_amdgcn_update_dpp(0, __builtin_bit_cast(int, x), ctrl, 0xf, 0xf, true))
DI v4i16_t tr_read(const LAS unsigned char* p) { return __builtin_amdgcn_ds_read_tr16_b64_v4i16((LAS v4i16_t*)p); }
struct AttnDecode { int b, h, d, c, n; };
DI AttnDecode attn_decode(int un) {
    AttnDecode u; const int bh = un / AT_UPB, iu = un % AT_UPB, p = iu >> 4, r = iu & 15; u.b = bh / NH; u.h = bh % NH;
    u.d = (p == 0) ? 1 : (p == 1) ? 4 : 16; u.c = (p == 0) ? 0 : (p == 1) ? (r >> 2) : r; u.n = (p == 0) ? r : (p == 1) ? (r & 3) : 0; return u;
}
struct AttnRegs { v4u k[AT_PASSES], v[AT_PASSES], q0[2], q1[2]; };
DI void attn_issue(const Frame& F, const Args& a, int un, AttnRegs& R) {
    const AttnDecode u = attn_decode(un); const bf16* proj = (const bf16*)(a.ws + WS_PH);
    const int r8 = F.tid >> 3, ch = F.tid & 7;
#pragma unroll
    for (int pass = 0; pass < AT_PASSES; ++pass) { int uk = 256 * u.n - 128 + pass * 64 + r8; uk = uk < 0 ? 0 : uk;
        const bf16* src = proj + ((size_t)u.b * SEQ + u.c + u.d * uk) * PP + 64 * u.h + 8 * ch;
        R.k[pass] = *(const GAS v4u*)(src + C_AK); R.v[pass] = *(const GAS v4u*)(src + C_AV); }
    const int qi = F.lane & 15, quad = F.lane >> 4;
#pragma unroll
    for (int tq = 0; tq < 2; ++tq) { const int uq = 256 * u.n + 32 * F.wave + 16 * tq + qi;
        const bf16* qsrc = proj + ((size_t)u.b * SEQ + u.c + u.d * uq) * PP + C_Q + 64 * u.h;
        R.q0[tq] = *(const GAS v4u*)(qsrc + 8 * quad); R.q1[tq] = *(const GAS v4u*)(qsrc + 32 + 8 * quad); }
}
DI void attn_unit(const Frame& F, const Args& a, int l, int un, float shift2, AttnRegs& R, int un_next) {
    const AttnDecode u = attn_decode(un); const int b = u.b, h = u.h, d = u.d, c = u.c, n = u.n, p = (d == 1) ? 0 : (d == 4) ? 1 : 2;
    unsigned char* ws = a.ws;
    const LAS float* gq = (const LAS float*)(F.lds + AT_GAIN); const LAS float* gk = gq + HD;
    const float slope = (h == 0) ? 0.25f : (h == 1) ? 0.0625f : (h == 2) ? 0.015625f : (h == 3) ? 0.00390625f : (h == 4) ? 0.5f : 0.125f;
    const float bco = -slope * (float)d * LOG2E;
    const int kb_lo = (n == 0) ? 128 : 0;
    LAS unsigned char* lds = F.lds + RING_OFF;
    {   const int r8 = F.tid >> 3, ch = F.tid & 7;
        const f32x4 g0 = *(const LAS f32x4*)(gk + 8 * ch), g1 = *(const LAS f32x4*)(gk + 8 * ch + 4);
#pragma unroll
        for (int pass = 0; pass < AT_PASSES; ++pass) {
            const int kb = pass * 64 + r8;
            float kf[8]; unpack8(R.k[pass], kf); float ss = 0.f;
#pragma unroll
            for (int j = 0; j < 8; ++j) ss += kf[j] * kf[j];
            ATT_DPP_ADD(ss, 0xB1); ATT_DPP_ADD(ss, 0x4E); ATT_DPP_ADD(ss, 0x141);
            const float sc = __builtin_amdgcn_rsqf(ss * (1.0f / HD) + 1e-6f);
#pragma unroll
            for (int j = 0; j < 8; ++j) kf[j] *= sc * (j < 4 ? g0[j] : g1[j - 4]);
            *(LAS v4u*)(lds + AT_K + kb * AT_PITCH + ch * 16) = pack8(kf);
            *(LAS v4u*)(lds + AT_V + kb * AT_PITCH + ch * 16) = R.v[pass];
        }
    }
    const int w = F.wave, qi = F.lane & 15, quad = F.lane >> 4;
    bf16x8 Qf0[2], Qf1[2];
    {   const f32x4 a0 = *(const LAS f32x4*)(gq + 8 * quad), a1 = *(const LAS f32x4*)(gq + 8 * quad + 4), b0 = *(const LAS f32x4*)(gq + 32 + 8 * quad), b1 = *(const LAS f32x4*)(gq + 32 + 8 * quad + 4);
#pragma unroll
        for (int tq = 0; tq < 2; ++tq) {
            float f0[8], f1[8]; unpack8(R.q0[tq], f0); unpack8(R.q1[tq], f1);
            float ss = 0.f;
#pragma unroll
            for (int j = 0; j < 8; ++j) ss += f0[j] * f0[j] + f1[j] * f1[j];
            ss += __shfl_xor(ss, 16); ss += __shfl_xor(ss, 32);
            const float sc = __builtin_amdgcn_rsqf(ss * (1.0f / HD) + 1e-6f) * (0.125f * LOG2E);
#pragma unroll
            for (int j = 0; j < 8; ++j) { f0[j] *= sc * (j < 4 ? a0[j] : a1[j - 4]); f1[j] *= sc * (j < 4 ? b0[j] : b1[j - 4]); }
            Qf0[tq] = __builtin_bit_cast(bf16x8, pack8(f0)); Qf1[tq] = __builtin_bit_cast(bf16x8, pack8(f1)); } }
    __syncthreads();
    if (un_next >= 0) attn_issue(F, a, un_next, R);
    f32x4 O[2][4];
#pragma unroll
    for (int tq = 0; tq < 2; ++tq)
#pragma unroll
        for (int dt = 0; dt < 4; ++dt) O[tq][dt] = (f32x4){0.f, 0.f, 0.f, 0.f};
    float lsum[2] = {0.f, 0.f};
    int g_lo = w; if (g_lo < (kb_lo >> 5)) g_lo = kb_lo >> 5;
    const int g_hi = w + 4, qpos0 = 128 + 32 * w + qi;
    float Bj[4]; int dq[4];
#pragma unroll
    for (int j = 0; j < 4; ++j) { dq[j] = qpos0 - 4 * quad - j; Bj[j] = bco * (float)dq[j] - shift2; }
    const float bt16 = bco * 16.0f;
    const f32x4 z4a = (f32x4){0.f, 0.f, 0.f, 0.f};
#pragma unroll 1
    for (int g = g_lo; g <= g_hi; ++g) {
        float pk[2][8];
        const bool interior = (g >= w + 1) && (g <= w + 3);
#pragma unroll
        for (int hf = 0; hf < 2; ++hf) {
            const int kb0 = 32 * g + 16 * hf; const float cgh = bco * (float)kb0;
            const LAS unsigned char* kaddr = lds + AT_K + (kb0 + qi) * AT_PITCH + quad * 16;
            const bf16x8 kf0 = *(const LAS bf16x8*)(kaddr), kf1 = *(const LAS bf16x8*)(kaddr + 64);
#pragma unroll
            for (int tq = 0; tq < 2; ++tq) {
                if ((tq == 0 && hf == 1 && g == w + 4) || (tq == 1 && hf == 0 && g == w)) {
#pragma unroll
                    for (int j = 0; j < 4; ++j) pk[tq][4 * hf + j] = 0.f;
                    continue; }
                f32x4 Sx = __builtin_amdgcn_mfma_f32_16x16x32_bf16(kf0, Qf0[tq], z4a, 0, 0, 0);
                Sx = __builtin_amdgcn_mfma_f32_16x16x32_bf16(kf1, Qf1[tq], Sx, 0, 0, 0);
                const float toff = tq ? bt16 : 0.f;
                if (interior) {
#pragma unroll
                    for (int j = 0; j < 4; ++j) { const float pv = __builtin_amdgcn_exp2f(Sx[j] + ((Bj[j] + toff) - cgh)); lsum[tq] += pv; pk[tq][4 * hf + j] = pv; }
                } else {
#pragma unroll
                    for (int j = 0; j < 4; ++j) { const int dist = dq[j] + 16 * tq - kb0;
                        const float pv = (dist >= 0 && dist <= 128) ? __builtin_amdgcn_exp2f(Sx[j] + ((Bj[j] + toff) - cgh)) : 0.f;
                        lsum[tq] += pv; pk[tq][4 * hf + j] = pv; }
                }
            }
        }
        const bf16x8 Pf0 = __builtin_bit_cast(bf16x8, pack8(pk[0])), Pf1 = __builtin_bit_cast(bf16x8, pack8(pk[1]));
        const LAS unsigned char* vaddr = lds + AT_V + (32 * g + 4 * quad + (qi >> 2)) * AT_PITCH + 8 * (qi & 3);
#pragma unroll
        for (int dt = 0; dt < 4; ++dt) {
            const v4i16_t lo = tr_read(vaddr + 32 * dt), hi = tr_read(vaddr + 32 * dt + 16 * AT_PITCH);
            const bf16x8 Vf = (bf16x8){lo[0], lo[1], lo[2], lo[3], hi[0], hi[1], hi[2], hi[3]};
            O[0][dt] = __builtin_amdgcn_mfma_f32_16x16x32_bf16(Vf, Pf0, O[0][dt], 0, 0, 0);
            O[1][dt] = __builtin_amdgcn_mfma_f32_16x16x32_bf16(Vf, Pf1, O[1][dt], 0, 0, 0);
        }
    }
#pragma unroll
    for (int tq = 0; tq < 2; ++tq) {
        float ls = lsum[tq]; ls += __shfl_xor(ls, 16); ls += __shfl_xor(ls, 32);
        const int uq = 256 * n + 32 * w + 16 * tq + qi; const size_t qrow = (size_t)b * SEQ + c + d * uq;
        bf16* dst = (p == 0) ? (bf16*)(ws + WS_MIX) + qrow * DM + DR + 64 * h : (p == 1) ? (bf16*)((unsigned char*)a.out + OUT_AP1) + qrow * DR + 64 * h : (bf16*)((unsigned char*)a.out + OUT_AP2) + qrow * DR + 64 * h;
#pragma unroll
        for (int dt = 0; dt < 4; ++dt) { v2u wv; wv.x = pk2(O[tq][dt][0], O[tq][dt][1]); wv.y = pk2(O[tq][dt][2], O[tq][dt][3]); *(GAS v2u*)(dst + 16 * dt + 4 * quad) = wv; }
        if (quad == 0) ((float*)((unsigned char*)a.out + OUT_ADEN))[((size_t)p * M + qrow) * 8 + h] = ls;
    }
    __syncthreads();
}
constexpr int N_SCAN_ITEMS = BATCH * NH, N_ATT_UNITS = BATCH * NH * AT_UPB;
#ifndef SCAN_REP
#define SCAN_REP 1
#endif
#ifndef ATT_REP
#define ATT_REP 1
#endif
#ifndef ATT_SCAN
#define ATT_SCAN 1
#endif
DI void phase5(const Frame& F, const Args& a, int l) {
    const int nsb = (F.G >= 2 * N_SCAN_ITEMS) ? N_SCAN_ITEMS : 0;
    if (F.bid < nsb) { for (int rep = 0; rep < SCAN_REP; ++rep) scan_bh(F, a, l, F.bid); }
    else if (nsb == 0) { for (int it = F.bid; it < N_SCAN_ITEMS; it += F.G) scan_bh(F, a, l, it); }
    const float gqv = a.in[I_QN][(size_t)l * HD + F.lane], gkv = a.in[I_KN][(size_t)l * HD + F.lane];
    const float gqm = wave_max(fabsf(gqv)), gkm = wave_max(fabsf(gkv));
    if (F.wave == 0) { ((LAS float*)(F.lds + AT_GAIN))[F.lane] = gqv; ((LAS float*)(F.lds + AT_GAIN))[HD + F.lane] = gkv; }
    __syncthreads();
    const float shift2 = 8.0f * gqm * gkm * LOG2E;
    int u0, u1;
    if (F.bid < nsb) { u0 = F.bid * ATT_SCAN; u1 = u0 + ATT_SCAN; }
    else { const int base = nsb * ATT_SCAN, nrest = N_ATT_UNITS - base, aw = F.bid - nsb, naw = F.G - nsb, per = nrest / naw, rem = nrest % naw;
        u0 = base + aw * per + (aw < rem ? aw : rem); u1 = u0 + per + (aw < rem ? 1 : 0); }
    for (int rep = 0; rep < ATT_REP; ++rep) { AttnRegs R;
        if (u0 < u1) attn_issue(F, a, u0, R);
        for (int un = u0; un < u1; ++un) attn_unit(F, a, l, un, shift2, R, (un + 1 < u1) ? un + 1 : -1); }
    if (F.bid >= nsb) { const int aw = F.bid - nsb, naw = F.G - nsb; conv_stage_taps(F, a, l);
        const int ncu = BATCH * (SEQ / CV_T), cper = ncu / naw, crem = ncu % naw, c0 = aw * cper + (aw < crem ? aw : crem), c1 = c0 + cper + (aw < crem ? 1 : 0);
        for (int cu = c0; cu < c1; ++cu) conv_unit(F, a, l, cu); }
}

struct PostRegs { v2u yv[4], vv[4], gv[4]; f32x4 rk; float lnw[4], lnb[4]; };
DI void rwkv_post_issue(const Frame& F, const Args& a, int l, int un, PostRegs& R) {
    const int bh = un / NSC, sc = un % NSC, b = bh / NH, h = bh % NH, quad = F.lane >> 4, il = F.lane & 15;
    unsigned char* ws = a.ws;
    const unsigned char* rec = rec_ptr(ws, b, h, sc); const unsigned char* gtp = gt_ptr(ws, (unsigned char*)a.out, b, h, sc);
    const unsigned char* yfp = (const unsigned char*)a.out + OUT_YF + ((size_t)(b * NH + h) * NSC + sc) * 2048 + F.lane * 8;
    R.rk = *(const GAS f32x4*)(rec + OFF_RK + 16 * quad);
#pragma unroll
    for (int r = 0; r < 4; ++r) { R.lnw[r] = a.in[I_LNW][(size_t)l * DR + 64 * h + 16 * r + il]; R.lnb[r] = a.in[I_LNB][(size_t)l * DR + 64 * h + 16 * r + il]; }
#pragma unroll
    for (int r = 0; r < 4; ++r) { R.yv[r] = *(const GAS v2u*)(yfp + r * 512); R.vv[r] = *(const GAS v2u*)(rec + OFF_VT + (r * 64 + F.lane) * 8); R.gv[r] = *(const GAS v2u*)(gtp + (r * 64 + F.lane) * 8); }
}
DI void rwkv_post_finish(const Frame& F, const Args& a, int l, int un, const PostRegs& R) {
    const int bh = un / NSC, sc = un % NSC, b = bh / NH, h = bh % NH, il = F.lane & 15, quad = F.lane >> 4;
    bf16* mixp = (bf16*)(a.ws + WS_MIX) + ((size_t)b * SEQ + 16 * sc + 4 * quad) * DM + 64 * h + il;
    float y[4][4], v[4][4], g[4][4];
#pragma unroll
    for (int r = 0; r < 4; ++r) { unpack4(R.yv[r], y[r]); unpack4(R.vv[r], v[r]); unpack4(R.gv[r], g[r]); }
#pragma unroll
    for (int e = 0; e < 4; ++e) {
        float s1 = 0.f, s2 = 0.f;
#pragma unroll
        for (int r = 0; r < 4; ++r) { s1 += y[r][e]; s2 += y[r][e] * y[r][e]; }
        s1 = row16_sum(s1); s2 = row16_sum(s2);
        const float mean = s1 * (1.0f / HD), var = s2 * (1.0f / HD) - mean * mean, rstd = __builtin_amdgcn_rsqf(fmaxf(var, 0.f) + 64e-5f);
#pragma unroll
        for (int r = 0; r < 4; ++r) { const float o = ((y[r][e] - mean) * rstd * R.lnw[r] + R.lnb[r] + R.rk[e] * v[r][e]) * g[r][e];
            *(GAS bf16*)(mixp + (size_t)e * DM + 16 * r) = (bf16)(pk2(o, 0.f) & 0xffffu); }
    }
}
DI void phase6(const Frame& F, const Args& a, int l) {
    const int gw = F.bid * NWAVES + F.wave, NGW = F.G * NWAVES;
    { PostRegs R0, R1;
      int un = gw; const int NU = BATCH * NH * NSC;
      if (un < NU) rwkv_post_issue(F, a, l, un, R0);
#pragma unroll 1
      for (; un < NU; un += 2 * NGW) {
          if (un + NGW < NU) rwkv_post_issue(F, a, l, un + NGW, R1);
          rwkv_post_finish(F, a, l, un, R0);
          if (un + NGW < NU) { if (un + 2 * NGW < NU) rwkv_post_issue(F, a, l, un + 2 * NGW, R0); rwkv_post_finish(F, a, l, un + NGW, R1); }
      } }
    const int ln = F.lane < 48 ? F.lane : F.lane - 16; const bool act = F.lane < 48;
    const int c0 = 8 * ln, hh = ln >> 3; unsigned char* ws = a.ws;
    bf16* mix = (bf16*)(ws + WS_MIX);
    const unsigned char* oscr = (const unsigned char*)a.out; const bf16* P1 = (const bf16*)(oscr + OUT_AP1); const bf16* P2 = (const bf16*)(oscr + OUT_AP2); const float* DEN = (const float*)(oscr + OUT_ADEN);
#pragma unroll 1
    for (int row0 = gw; row0 < M; row0 += 8 * NGW) {
        v4u n0[8], n1[8], n2[8]; float den[8];
#pragma unroll
        for (int k = 0; k < 8; ++k) { int row = row0 + k * NGW; row = row < M ? row : row0;
            n0[k] = *(const GAS v4u*)(mix + (size_t)row * DM + DR + c0); n1[k] = *(const GAS v4u*)(P1 + (size_t)row * DR + c0); n2[k] = *(const GAS v4u*)(P2 + (size_t)row * DR + c0);
            den[k] = DEN[(size_t)row * 8 + hh] + DEN[((size_t)M + row) * 8 + hh] + DEN[((size_t)2 * M + row) * 8 + hh]; }
#pragma unroll
        for (int k = 0; k < 8; ++k) { const int row = row0 + k * NGW; float f0[8], f1[8], f2[8], o[8]; unpack8(n0[k], f0); unpack8(n1[k], f1); unpack8(n2[k], f2);
            const float rd = 1.0f / den[k];
#pragma unroll
            for (int j = 0; j < 8; ++j) o[j] = (f0[j] + f1[j] + f2[j]) * rd;
            if (act && row < M) *(GAS v4u*)(mix + (size_t)row * DM + DR + c0) = pack8(o); }
    }
}

#ifndef MK_SINGLE
#define MK_SINGLE 1
#endif
__global__ void __launch_bounds__(NWAVES * 64, 2) mk_fwd(Args args) {
    extern __shared__ __attribute__((aligned(16))) unsigned char lds[];
    Frame F;
    F.lds = (LAS unsigned char*)lds;
    F.MISC = (volatile LAS unsigned*)(F.lds + MISC_OFF);
    F.tid = threadIdx.x; F.lane = F.tid & 63; F.wave = __builtin_amdgcn_readfirstlane(F.tid >> 6);
    F.G = gridDim.x; F.bid = blockIdx.x;
    unsigned char* ws = args.ws;
    F.ctl = (gu32*)(ws + WS_CTL);
    for (int u = F.tid; u < (LDS_BYTES - LDSCTL_OFF) / 4; u += NWAVES * 64) ((LAS unsigned*)(F.lds + LDSCTL_OFF))[u] = 0u;
    __syncthreads();
    XcdBarrier bar; bar.bar = (unsigned*)(F.ctl + CW_BAR); bar.x = 0; bar.st = nullptr;
    if (args.single) bar = xcd_barrier_post((unsigned*)(F.ctl + CW_BAR), F.MISC + 8);
#define GRID_BAR() do { if (args.single) xcd_barrier(bar); } while (0)
    const int lo = args.ph_lo, hi = args.ph_hi;
#ifndef PH_MASK
#define PH_MASK 0x3ff
#endif
#define IN(k) (((PH_MASK >> (k)) & 1) && lo <= (k) && (k) < hi)
#ifndef DUP_MASK
#define DUP_MASK 0
#endif
#define REP(k) for (int rep_ = 0; rep_ < (((DUP_MASK >> (k)) & 1) ? 2 : 1); ++rep_)
    const pg8::bf16_t* XB = (const pg8::bf16_t*)(ws + WS_XB); pg8::bf16_t* PH = (pg8::bf16_t*)(ws + WS_PH); pg8::bf16_t* MIXB = (pg8::bf16_t*)(ws + WS_MIX); float* RSQ = (float*)(ws + WS_RSQ);
#pragma unroll 1
    for (int l = args.l_lo; l < args.l_hi; ++l) {
        { int t_ = threadIdx.x; asm volatile("" : "+v"(t_)); F.tid = t_; F.lane = t_ & 63; F.wave = __builtin_amdgcn_readfirstlane(t_ >> 6); }
        if (IN(0)) REP(0) { phase0(F, args, l); GRID_BAR(); }
        if (IN(1)) REP(1) {
            pg8::Gemm g{XB, (const pg8::bf16_t*)(ws + W_UP1), M, NUP, DM}; pg8::StaticOrder S; S.init(M, NUP, F.G, F.bid);
            pg8::EpiSwiglu E{PH, FF, RSQ, (LAS float*)(F.lds + LDSCTL_OFF + 1024)};
            pg8::gemm_phase<pg8::EpiSwiglu, pg8::StaticOrder, true, true>(F.lds + RING_OFF, g, S, E);
            GRID_BAR(); }
        if (IN(2)) REP(2) {
            pg8::Gemm g{PH, (const pg8::bf16_t*)(ws + W_DN1), M, DM, FF}; pg8::StaticOrder S; S.init(M, DM, F.G, F.bid);
            pg8::EpiResidual E{nullptr, (pg8::bf16_t*)(ws + WS_XB), RSQ, DM};
            pg8::gemm_phase<pg8::EpiResidual, pg8::StaticOrder, true, true>(F.lds + RING_OFF, g, S, E);
            GRID_BAR(); }
        if (IN(3)) REP(3) {
            pg8::Gemm g{XB, (const pg8::bf16_t*)(ws + W_IN), M, PP, DM}; pg8::StaticOrder S; S.init(M, PP, F.G, F.bid);
            pg8::EpiProj E{PH, PP, RSQ, (LAS float*)(F.lds + LDSCTL_OFF + 1024)};
            pg8::gemm_phase<pg8::EpiProj, pg8::StaticOrder, true, true>(F.lds + RING_OFF, g, S, E);
            GRID_BAR(); }
        if (IN(4)) REP(4) { phase4(F, args, l); GRID_BAR(); }
        if (IN(5)) REP(5) { phase5(F, args, l); GRID_BAR(); }
        if (IN(6)) REP(6) { phase6(F, args, l); GRID_BAR(); }
        if (IN(7)) REP(7) {
            pg8::Gemm g{MIXB, (const pg8::bf16_t*)(ws + W_OUT), M, DM, DM}; pg8::StaticOrder S; S.init(M, DM, F.G, F.bid);
            pg8::EpiResidual E{nullptr, (pg8::bf16_t*)(ws + WS_XB), RSQ, DM};
            pg8::gemm_phase<pg8::EpiResidual, pg8::StaticOrder, true, true>(F.lds + RING_OFF, g, S, E);
            GRID_BAR(); }
        if (IN(8)) REP(8) {
            pg8::Gemm g{XB, (const pg8::bf16_t*)(ws + W_UP2), M, NUP, DM}; pg8::StaticOrder S; S.init(M, NUP, F.G, F.bid);
            pg8::EpiSwiglu E{PH, FF, RSQ, (LAS float*)(F.lds + LDSCTL_OFF + 1024)};
            pg8::gemm_phase<pg8::EpiSwiglu, pg8::StaticOrder, true, true>(F.lds + RING_OFF, g, S, E);
            GRID_BAR(); }
        if (IN(9)) REP(9) {
            pg8::Gemm g{PH, (const pg8::bf16_t*)(ws + W_DN2), M, DM, FF}; pg8::StaticOrder S; S.init(M, DM, F.G, F.bid);
            pg8::EpiResidual E{(l == DEPTH - 1) ? args.out : nullptr, (pg8::bf16_t*)(ws + WS_XB), RSQ, DM};
            pg8::gemm_phase<pg8::EpiResidual, pg8::StaticOrder, true, true>(F.lds + RING_OFF, g, S, E);
            GRID_BAR(); }
    }
#undef IN
#undef GRID_BAR
}

extern "C" void kernel_launch(void* const* d_in, const int* in_sizes, int n_in, void* d_out, int out_size, void* d_ws, size_t ws_size, hipStream_t stream) {
    static int grid = 0;
    if (grid == 0) {
        if (n_in != N_IN || in_sizes[0] != M * DM || out_size != M * DM || ws_size < WS_END) { fprintf(stderr, "kernel_launch: unexpected shapes (n_in %d, in0 %d, out %d, ws %zu < %zu); nothing launched\n", n_in, n_in > 0 ? in_sizes[0] : -1, out_size, ws_size, (size_t)WS_END); grid = -1; return; }
        int dev = 0, cus = 0, per_cu = 0;
        if (hipGetDevice(&dev) != hipSuccess || hipDeviceGetAttribute(&cus, hipDeviceAttributeMultiprocessorCount, dev) != hipSuccess) { grid = -1; return; }
        if (hipFuncSetAttribute((const void*)mk_fwd, hipFuncAttributeMaxDynamicSharedMemorySize, LDS_BYTES) != hipSuccess) { fprintf(stderr, "kernel_launch: hipFuncSetAttribute failed\n"); grid = -1; return; }
        if (hipOccupancyMaxActiveBlocksPerMultiprocessor(&per_cu, (const void*)mk_fwd, NWAVES * 64, LDS_BYTES) != hipSuccess || per_cu < 1) fprintf(stderr, "kernel_launch: occupancy query reports %d\n", per_cu);
        (void)hipGetLastError();
        grid = cus;
    }
    if (grid < 0) return;
    if (hipMemsetAsync((char*)d_ws + WS_CTL, 0, CTL_ZERO_BYTES, stream) != hipSuccess) return;
    Args a{};
    for (int i = 0; i < N_IN; ++i) a.in[i] = (const float*)d_in[i];
    a.out = (float*)d_out; a.ws = (unsigned char*)d_ws; a.pad = 0;
#if MK_SINGLE
    a.l_lo = 0; a.l_hi = DEPTH; a.ph_lo = 0; a.ph_hi = NPH; a.single = 1;
    hipLaunchKernelGGL(mk_fwd, dim3(grid), dim3(NWAVES * 64), LDS_BYTES, stream, a);
#else
    for (int l = 0; l < DEPTH; ++l)
        for (int ph = 0; ph < NPH; ++ph) { a.l_lo = l; a.l_hi = l + 1; a.ph_lo = ph; a.ph_hi = ph + 1; a.single = 0;
            hipLaunchKernelGGL(mk_fwd, dim3(grid), dim3(NWAVES * 64), LDS_BYTES, stream, a); }
#endif
}
```

```cpp
#include <hip/hip_runtime.h>
#include <cstdio>
#include <cstdint>
#define MK_SINGLE 1
namespace pg8 {
#define PG8_LAS __attribute__((address_space(3)))
typedef unsigned short bf16_t;
typedef short bf16x8 __attribute__((ext_vector_type(8)));
typedef float f32x4 __attribute__((ext_vector_type(4)));
typedef unsigned u32x4 __attribute__((ext_vector_type(4)));
constexpr int BM = 256, BK = 64, HALF = 128, HTB = HALF * BK * 2  , STAGE_BYTES = 8 * HTB, NXCD = 8, WGM = 8;

__host__ __device__ __forceinline__ int lds_byte(int r, int c) { const int st = (r >> 4) * 2 + (c >> 5), rr = r & 15, cc = c & 31, ob = rr * 64 + cc * 2; return st * 1024 + (ob ^ (((ob >> 9) & 1) << 5)); }
__host__ __device__ __forceinline__ void stage_rc(int b, int& R, int& C) { const int st = b / 1024, sb = b % 1024, swz = sb ^ (((sb >> 9) & 1) << 5); R = (st >> 1) * 16 + swz / 64; C = (st & 1) * 32 + (swz % 64) / 2; }
__host__ __device__ __forceinline__ int perm32(int rho) { const int n = rho >> 4, i = rho & 15; return 8 * (i >> 2) + 4 * n + (i & 3); }

struct Unit { int pm, pn; };
struct Gemm { const bf16_t* A; const bf16_t* Bt; int M, N, K; };

struct StaticOrder {
    int nM, nN, nwg, G, c;
    __host__ __device__ void init(int M, int N, int G_, int c_) { nM = M / BM; nN = N / BM; nwg = nM * nN; G = G_; c = c_; }
    __host__ __device__ bool next(int i, Unit& u) const {
        const long L = (long)i * G + c; if (L >= nwg) return false;
        int wgid = (int)L; { const int q = nwg / NXCD, r = nwg % NXCD, xcd = wgid % NXCD, off = wgid / NXCD; wgid = (xcd < r ? xcd * (q + 1) : r * (q + 1) + (xcd - r) * q) + off; }
        const int nig = WGM * nN, gid = wgid / nig, fm = gid * WGM, gsz = (nM % WGM == 0) ? WGM : ((nM - fm) < WGM ? (nM - fm) : WGM);
        u.pm = fm + ((wgid % nig) % gsz); u.pn = (wgid % nig) / gsz; return true;
    }
    __device__ __forceinline__ void a_ready(const Unit&) const {}
    __device__ __forceinline__ void done(const Unit&) const {}
};

__device__ __forceinline__ unsigned cvt_pk_bf16(float lo, float hi) { unsigned r; asm volatile("v_cvt_pk_bf16_f32 %0, %1, %2" : "=v"(r) : "v"(lo), "v"(hi)); return r; }
typedef float f32x2 __attribute__((ext_vector_type(2)));

__device__ __forceinline__ float row_scale(const float* rowsq, int row) {
    const f32x4* p = (const f32x4*)(rowsq + (size_t)row * 16);
    const f32x4 a = p[0], b = p[1], c = p[2], d = p[3];
    const float s = ((a[0] + a[1]) + (a[2] + a[3])) + ((b[0] + b[1]) + (b[2] + b[3])) + ((c[0] + c[1]) + (c[2] + c[3])) + ((d[0] + d[1]) + (d[2] + d[3]));
    return __builtin_amdgcn_rsqf(s * (1.0f / 1024.0f) + 1e-6f);
}
__device__ __forceinline__ void row_scales8(const float* rowsq, int row0, int fr, int fq, float (&s)[8]) {
    const int k0 = 2 * fq, k1 = 2 * fq + 1;
    const float sA = row_scale(rowsq, row0 + (k0 >> 2) * HALF + (k0 & 3) * 16), sB = row_scale(rowsq, row0 + (k1 >> 2) * HALF + (k1 & 3) * 16);
#pragma unroll
    for (int q = 0; q < 4; ++q) { s[2 * q] = __shfl(sA, fr + 16 * q); s[2 * q + 1] = __shfl(sB, fr + 16 * q); }
}
__device__ __forceinline__ void row_scales8_cached(const float* rowsq, PG8_LAS float* sc, bool fresh, int row0, int lrow0, int wc, int fr, int fq, float (&s)[8]) {
    if (fresh) {
        row_scales8(rowsq, row0, fr, fq, s);
        if (wc == 0 && fq == 0) {
#pragma unroll
            for (int k = 0; k < 8; ++k) sc[lrow0 + (k >> 2) * HALF + (k & 3) * 16] = s[k];
        }
    } else {
#pragma unroll
        for (int k = 0; k < 8; ++k) s[k] = sc[lrow0 + (k >> 2) * HALF + (k & 3) * 16];
    }
}
__device__ __forceinline__ float silu_f(float x) { return x * __builtin_amdgcn_rcpf(1.0f + __expf(-x)); }

struct EpiSwiglu {
    static constexpr bool PERM = true, AFTER_DRAIN = false;
    bf16_t* H; int ldh; const float* rowsq; PG8_LAS float* sc;
    __device__ __forceinline__ void operator()(const f32x4 (&acc)[2][2][4][2], const Unit& u, int wr, int wc, int fr, int fq, bool fresh) const {
        const int row0 = u.pm * BM + wr * 64 + fr, col0 = u.pn * HALF + wc * 32 + 8 * fq;
        float s8[8]; row_scales8_cached(rowsq, sc, fresh, row0, wr * 64 + fr, wc, fr, fq, s8);
#pragma unroll
        for (int ai = 0; ai < 2; ++ai)
#pragma unroll
            for (int m = 0; m < 4; ++m) {
                const int row = row0 + ai * HALF + m * 16; const float s = s8[4 * ai + m];
                const float c1 = -1.4426950408889634f * s, is2 = __builtin_amdgcn_rcpf(s * s);
                u32x4 w;
#pragma unroll
                for (int n = 0; n < 2; ++n) {
                    const f32x4 g = acc[ai][0][m][n], up = acc[ai][1][m][n];
                    const f32x4 t = g * c1;
                    f32x4 e; e[0] = __builtin_amdgcn_exp2f(t[0]); e[1] = __builtin_amdgcn_exp2f(t[1]); e[2] = __builtin_amdgcn_exp2f(t[2]); e[3] = __builtin_amdgcn_exp2f(t[3]);
                    const f32x4 d = e * is2 + is2;
                    f32x4 r; r[0] = __builtin_amdgcn_rcpf(d[0]); r[1] = __builtin_amdgcn_rcpf(d[1]); r[2] = __builtin_amdgcn_rcpf(d[2]); r[3] = __builtin_amdgcn_rcpf(d[3]);
                    const f32x4 h = (g * up) * r;
                    if (n == 0) { w.x = cvt_pk_bf16(h[0], h[1]); w.y = cvt_pk_bf16(h[2], h[3]); } else { w.z = cvt_pk_bf16(h[0], h[1]); w.w = cvt_pk_bf16(h[2], h[3]); }
                }
                *(u32x4*)(H + (size_t)row * ldh + col0) = w;
            }
    }
};
struct EpiProj {
    static constexpr bool PERM = true, AFTER_DRAIN = false;
    bf16_t* O; int ldc; const float* rowsq; PG8_LAS float* sc;
    __device__ __forceinline__ void operator()(const f32x4 (&acc)[2][2][4][2], const Unit& u, int wr, int wc, int fr, int fq, bool fresh) const {
        const int row0 = u.pm * BM + wr * 64 + fr, col0 = u.pn * BM + wc * 32 + 8 * fq;
        float s8[8]; row_scales8_cached(rowsq, sc, fresh, row0, wr * 64 + fr, wc, fr, fq, s8);
#pragma unroll
        for (int ai = 0; ai < 2; ++ai)
#pragma unroll
            for (int m = 0; m < 4; ++m) {
                const int row = row0 + ai * HALF + m * 16; const float s = s8[4 * ai + m];
#pragma unroll
                for (int bj = 0; bj < 2; ++bj) { if (u.pn * BM + bj * HALF >= 2944) continue;
                    const f32x4 v0 = acc[ai][bj][m][0] * s, v1 = acc[ai][bj][m][1] * s;
                    u32x4 w; w.x = cvt_pk_bf16(v0[0], v0[1]); w.y = cvt_pk_bf16(v0[2], v0[3]); w.z = cvt_pk_bf16(v1[0], v1[1]); w.w = cvt_pk_bf16(v1[2], v1[3]);
                    *(u32x4*)(O + (size_t)row * ldc + col0 + bj * HALF) = w; }
            }
    }
};
struct EpiResidual {
    static constexpr bool PERM = true, AFTER_DRAIN = false;
    float* out; bf16_t* xb; float* rowsq; int ldc;
    __device__ __forceinline__ void operator()(const f32x4 (&acc)[2][2][4][2], const Unit& u, int wr, int wc, int fr, int fq, bool) const {
        const int row0 = u.pm * BM + wr * 64 + fr, col0 = u.pn * BM + wc * 32 + 8 * fq;
        u32x4 b0[4][2], b1[4][2];
#pragma unroll
        for (int m = 0; m < 4; ++m)
#pragma unroll
            for (int bj = 0; bj < 2; ++bj) b0[m][bj] = *(const u32x4*)(xb + (size_t)(row0 + m * 16) * ldc + col0 + bj * HALF);
        asm volatile("" ::: "memory");
#pragma unroll
        for (int ai = 0; ai < 2; ++ai) {
#pragma unroll
            for (int m = 0; m < 4; ++m) {
                const int row = row0 + ai * HALF + m * 16; float ss = 0.f;
                if (ai == 0) {
#pragma unroll
                    for (int bj = 0; bj < 2; ++bj) b1[m][bj] = *(const u32x4*)(xb + (size_t)(row0 + HALF + m * 16) * ldc + col0 + bj * HALF);
                    asm volatile("" ::: "memory");
                }
#pragma unroll
                for (int bj = 0; bj < 2; ++bj) { const size_t off = (size_t)row * ldc + col0 + bj * HALF;
                    const u32x4 b = ai == 0 ? b0[m][bj] : b1[m][bj];
                    f32x4 v0, v1;
                    v0[0] = __builtin_bit_cast(float, b.x << 16) + acc[ai][bj][m][0][0]; v0[1] = __builtin_bit_cast(float, b.x & 0xffff0000u) + acc[ai][bj][m][0][1];
                    v0[2] = __builtin_bit_cast(float, b.y << 16) + acc[ai][bj][m][0][2]; v0[3] = __builtin_bit_cast(float, b.y & 0xffff0000u) + acc[ai][bj][m][0][3];
                    v1[0] = __builtin_bit_cast(float, b.z << 16) + acc[ai][bj][m][1][0]; v1[1] = __builtin_bit_cast(float, b.z & 0xffff0000u) + acc[ai][bj][m][1][1];
                    v1[2] = __builtin_bit_cast(float, b.w << 16) + acc[ai][bj][m][1][2]; v1[3] = __builtin_bit_cast(float, b.w & 0xffff0000u) + acc[ai][bj][m][1][3];
                    if (out) { *(f32x4*)(out + off) = v0; *(f32x4*)(out + off + 4) = v1; }
                    else {
                    const f32x4 q = v0 * v0 + v1 * v1;
                    ss += (q[0] + q[1]) + (q[2] + q[3]);
                    u32x4 w; w.x = cvt_pk_bf16(v0[0], v0[1]); w.y = cvt_pk_bf16(v0[2], v0[3]); w.z = cvt_pk_bf16(v1[0], v1[1]); w.w = cvt_pk_bf16(v1[2], v1[3]);
                    *(u32x4*)(xb + off) = w; } }
                if (!out) { ss += __shfl_xor(ss, 16); ss += __shfl_xor(ss, 32);
                    if (fq == 0) rowsq[(size_t)row * 16 + u.pn * 4 + wc] = ss; }
                asm volatile("" ::: "memory");
            }
        }
    }
};


template <class Epi, class Sched, bool ALIGN_EPI = false, bool SP2 = false>
__device__ __forceinline__ void gemm_phase(PG8_LAS unsigned char* lds, const Gemm g, const Sched& S, const Epi& E) {
    int tid_ = threadIdx.x; asm volatile("" : "+v"(tid_));
    const int tid = tid_, wid = __builtin_amdgcn_readfirstlane(tid >> 6), lane = tid & 63, wr = wid >> 2, wc = wid & 3, fr = lane & 15, fq = lane >> 4;
    const int K = g.K, nt = K / BK;
    unsigned voffA[2], voffB[2];
#pragma unroll
    for (int i = 0; i < 2; ++i) { int R, C; stage_rc(tid * 16 + i * 8192, R, C); const int Rb = Epi::PERM ? ((R & ~31) + perm32(R & 31)) : R;
        voffA[i] = (unsigned)(R * K + C) * 2u; voffB[i] = (unsigned)(Rb * K + C) * 2u; }
    const size_t kstep = (size_t)(BK * 2);
    const size_t hstep = (size_t)HALF * K * 2;
    const size_t tstep = 2 * hstep;
    const unsigned ldsw = (unsigned)wid * 1024u;
    const int aoff = lds_byte(wr * 64 + fr, fq * 8), boff = lds_byte(wc * 32 + fr, fq * 8);
#define PG8_SA(b, h) (((b) * 2 + (h)) * HTB)
#define PG8_SB(b, h) ((4 + (b) * 2 + (h)) * HTB)
#define PG8_STAGE(bufoff, gbase, voff) do { _Pragma("unroll") for (int _i = 0; _i < 2; ++_i) \
        __builtin_amdgcn_global_load_lds((const unsigned*)((const char*)(gbase) + (voff)[_i]), (PG8_LAS unsigned*)(lds + (bufoff) + ldsw + _i * 8192), 16, 0, 0); } while (0)
#define PG8_LDA(dst, b, h) do { _Pragma("unroll") for (int m = 0; m < 4; ++m) _Pragma("unroll") for (int k = 0; k < 2; ++k) dst[m][k] = *(const PG8_LAS bf16x8*)(lds + PG8_SA(b, h) + aoff + m * 2048 + k * 1024); } while (0)
#define PG8_LDB(dst, b, h) do { _Pragma("unroll") for (int n = 0; n < 2; ++n) _Pragma("unroll") for (int k = 0; k < 2; ++k) dst[n][k] = *(const PG8_LAS bf16x8*)(lds + PG8_SB(b, h) + boff + n * 2048 + k * 1024); } while (0)
#define PG8_MMA(ai, bj, At, Bt) do { __builtin_amdgcn_s_setprio(1); _Pragma("unroll") for (int m = 0; m < 4; ++m) _Pragma("unroll") for (int n = 0; n < 2; ++n) _Pragma("unroll") for (int k = 0; k < 2; ++k) \
        acc[ai][bj][m][n] = __builtin_amdgcn_mfma_f32_16x16x32_bf16(Bt[n][k], At[m][k], acc[ai][bj][m][n], 0, 0, 0); __builtin_amdgcn_s_setprio(0); } while (0)
#define PG8_WAIT_V(n) asm volatile("s_waitcnt vmcnt(" #n ")" ::: "memory")
#define PG8_WAIT_L(n) asm volatile("s_waitcnt lgkmcnt(" #n ")" ::: "memory")
#define PG8_BAR __builtin_amdgcn_s_barrier()
#define PG8_SCHED __builtin_amdgcn_sched_barrier(0)
    Unit cur, nxt; int ui = 0, ppm = -1;
    if (!S.next(0, cur)) return;
    f32x4 acc[2][2][4][2];
#pragma unroll
    for (int a = 0; a < 2; ++a)
#pragma unroll
        for (int b = 0; b < 2; ++b)
#pragma unroll
            for (int m = 0; m < 4; ++m)
#pragma unroll
                for (int n = 0; n < 2; ++n) acc[a][b][m][n] = (f32x4){0.f, 0.f, 0.f, 0.f};
    bf16x8 At[4][2], B0[2][2], B1[2][2];
    const char* cA = (const char*)g.A + (size_t)cur.pm * tstep; const char* cB = (const char*)g.Bt + (size_t)cur.pn * tstep;
    S.a_ready(cur);
    if constexpr (SP2) {
        PG8_STAGE(PG8_SB(0, 0), cB, voffB); PG8_STAGE(PG8_SB(0, 1), cB + hstep, voffB); PG8_STAGE(PG8_SA(0, 0), cA, voffA); PG8_STAGE(PG8_SA(0, 1), cA + hstep, voffA);
        if (wr == 1) PG8_BAR;
        PG8_WAIT_V(2); PG8_BAR;
        PG8_STAGE(PG8_SB(1, 0), cB + kstep, voffB); PG8_STAGE(PG8_SA(1, 0), cA + kstep, voffA); PG8_STAGE(PG8_SB(1, 1), cB + hstep + kstep, voffB);
        PG8_WAIT_V(6); PG8_BAR;
    } else {
        PG8_STAGE(PG8_SB(0, 0), cB, voffB); PG8_STAGE(PG8_SA(0, 0), cA, voffA); PG8_STAGE(PG8_SB(0, 1), cB + hstep, voffB); PG8_STAGE(PG8_SA(0, 1), cA + hstep, voffA);
        if (wr == 1) PG8_BAR;
        PG8_WAIT_V(4); PG8_BAR;
        PG8_STAGE(PG8_SB(1, 0), cB + kstep, voffB); PG8_STAGE(PG8_SA(1, 0), cA + kstep, voffA); PG8_STAGE(PG8_SB(1, 1), cB + hstep + kstep, voffB);
        PG8_WAIT_V(6); PG8_BAR;
    }
    for (;;) {
        const bool has_next = S.next(ui + 1, nxt);
        const char* nA = has_next ? (const char*)g.A + (size_t)nxt.pm * tstep : cA; const char* nB = has_next ? (const char*)g.Bt + (size_t)nxt.pn * tstep : cB;
        for (int t = 0; t < nt; t += 2) {
            const bool last = (t == nt - 2);
            const char* a1 = cA + (size_t)(t + 1) * kstep;
            const char* a2 = last ? nA : cA + (size_t)(t + 2) * kstep; const char* b2 = last ? nB : cB + (size_t)(t + 2) * kstep;
            const char* a3 = a2 + kstep; const char* b3 = b2 + kstep;
            if (last && has_next) S.a_ready(nxt);
            if constexpr (SP2) {
            PG8_LDB(B0, 0, 0); PG8_LDB(B1, 0, 1); PG8_SCHED; PG8_LDA(At, 0, 0); PG8_STAGE(PG8_SA(1, 1), a1 + hstep, voffA);
            PG8_WAIT_V(8); PG8_WAIT_L(0); PG8_BAR; PG8_MMA(0, 0, At, B0); PG8_MMA(0, 1, At, B1); PG8_BAR; PG8_SCHED;
            PG8_LDA(At, 0, 1); PG8_STAGE(PG8_SB(0, 0), b2, voffB); PG8_STAGE(PG8_SB(0, 1), b2 + hstep, voffB); PG8_STAGE(PG8_SA(0, 0), a2, voffA);
            PG8_WAIT_V(8); PG8_WAIT_L(0); PG8_BAR; PG8_MMA(1, 0, At, B0); PG8_MMA(1, 1, At, B1); PG8_BAR; PG8_SCHED;
            PG8_LDB(B0, 1, 0); PG8_LDB(B1, 1, 1); PG8_SCHED; PG8_LDA(At, 1, 0); PG8_STAGE(PG8_SA(0, 1), a2 + hstep, voffA);
            PG8_WAIT_V(8); PG8_WAIT_L(0); PG8_BAR; PG8_MMA(0, 0, At, B0); PG8_MMA(0, 1, At, B1); PG8_BAR; PG8_SCHED;
            PG8_LDA(At, 1, 1); PG8_STAGE(PG8_SB(1, 0), b3, voffB); PG8_STAGE(PG8_SB(1, 1), b3 + hstep, voffB); PG8_STAGE(PG8_SA(1, 0), a3, voffA);
            PG8_WAIT_V(8); PG8_WAIT_L(0); PG8_BAR; PG8_MMA(1, 0, At, B0); PG8_MMA(1, 1, At, B1); PG8_BAR; PG8_SCHED;
            } else {
            PG8_LDB(B0, 0, 0); PG8_SCHED; PG8_LDA(At, 0, 0); PG8_STAGE(PG8_SA(1, 1), a1 + hstep, voffA);
            PG8_WAIT_L(8); PG8_BAR; PG8_WAIT_L(0); PG8_MMA(0, 0, At, B0); PG8_BAR; PG8_SCHED;
            PG8_LDB(B1, 0, 1); PG8_STAGE(PG8_SB(0, 0), b2, voffB);
            PG8_BAR; PG8_WAIT_L(0); PG8_MMA(0, 1, At, B1); PG8_BAR;
            PG8_LDA(At, 0, 1); PG8_STAGE(PG8_SA(0, 0), a2, voffA);
            PG8_BAR; PG8_WAIT_L(0); PG8_MMA(1, 0, At, B0); PG8_BAR; PG8_SCHED;
            PG8_STAGE(PG8_SB(0, 1), b2 + hstep, voffB);
            PG8_WAIT_V(6); PG8_BAR; PG8_MMA(1, 1, At, B1); PG8_BAR;
            PG8_LDB(B0, 1, 0); PG8_SCHED; PG8_LDA(At, 1, 0); PG8_STAGE(PG8_SA(0, 1), a2 + hstep, voffA);
            PG8_WAIT_L(8); PG8_BAR; PG8_WAIT_L(0); PG8_MMA(0, 0, At, B0); PG8_BAR; PG8_SCHED;
            PG8_LDB(B1, 1, 1); PG8_STAGE(PG8_SB(1, 0), b3, voffB);
            PG8_BAR; PG8_WAIT_L(0); PG8_MMA(0, 1, At, B1); PG8_BAR;
            PG8_LDA(At, 1, 1); PG8_STAGE(PG8_SA(1, 0), a3, voffA);
            PG8_BAR; PG8_WAIT_L(0); PG8_MMA(1, 0, At, B0); PG8_BAR; PG8_SCHED;
            PG8_STAGE(PG8_SB(1, 1), b3 + hstep, voffB);
            PG8_WAIT_V(6); PG8_BAR; PG8_MMA(1, 1, At, B1); PG8_BAR;
            }
        }
        if constexpr (ALIGN_EPI) { if (wr == 0) PG8_BAR; }
        if constexpr (!Epi::AFTER_DRAIN) { E(acc, cur, wr, wc, fr, fq, cur.pm != ppm); ppm = cur.pm; S.done(cur); }
        if (!has_next) break;
#pragma unroll
        for (int a = 0; a < 2; ++a)
#pragma unroll
            for (int b = 0; b < 2; ++b)
#pragma unroll
                for (int m = 0; m < 4; ++m)
#pragma unroll
                    for (int n = 0; n < 2; ++n) acc[a][b][m][n] = (f32x4){0.f, 0.f, 0.f, 0.f};
        cur = nxt; cA = nA; cB = nB; ++ui;
        if constexpr (ALIGN_EPI) { if (wr == 1) PG8_BAR; }
    }
    PG8_WAIT_V(0);
    if constexpr (!ALIGN_EPI) { if (wr == 0) PG8_BAR; }
    PG8_BAR;
    if constexpr (Epi::AFTER_DRAIN) { E.fused(acc, cur, wr, wc, fr, fq, lds, wid, lane); S.done(cur); }
#undef PG8_SA
#undef PG8_SB
#undef PG8_STAGE
#undef PG8_LDA
#undef PG8_LDB
#undef PG8_MMA
#undef PG8_WAIT_V
#undef PG8_WAIT_L
#undef PG8_BAR
#undef PG8_SCHED
}
}

constexpr int NWAVES = 8;
constexpr int BATCH = 8, SEQ = 4096, DM = 1024, DEPTH = 4, M = BATCH * SEQ;
constexpr int FF = 2816, NUP = 2 * FF, DIN = 2944, PP = 3072;
constexpr int DR = 384, NH = 6, HD = 64, DSHIFT = 1280, DC = 256, CW = 31;
constexpr int C_R = 0, C_K = 384, C_V = 768, C_XW = 1152, C_XA = 1184, C_XG = 1216, C_Q = 1280, C_AK = 1664, C_AV = 2048, C_CU = 2432, C_CG = 2688;
constexpr int NPH = 10;
constexpr float LOG2E = 1.4426950408889634f;
enum { I_X = 0, I_NF1, I_WG1, I_WU1, I_WD1, I_NMIX, I_WIN, I_MU, I_W0, I_W2, I_A0, I_A2, I_G2, I_KK, I_KA, I_RK, I_LNW, I_LNB, I_QN, I_KN, I_CW, I_CB, I_CLW, I_CLB, I_WOUT, I_NF2, I_WG2, I_WU2, I_WD2, N_IN };

constexpr size_t MiB = 1u << 20;
constexpr size_t WS_CTL = 0, CTL_ZERO_BYTES = 32768;
constexpr size_t WS_LORA = 2 * MiB;
constexpr size_t WS_W = 4 * MiB;
constexpr size_t W_UP1 = WS_W, W_DN1 = W_UP1 + (size_t)NUP * DM * 2, W_IN = W_DN1 + (size_t)DM * FF * 2, W_OUT = W_IN + (size_t)PP * DM * 2,
                 W_UP2 = W_OUT + (size_t)DM * DM * 2, W_DN2 = W_UP2 + (size_t)NUP * DM * 2, W_END = W_DN2 + (size_t)DM * FF * 2;
constexpr size_t WS_XB = 48 * MiB;
constexpr size_t WS_PH = 112 * MiB;
constexpr size_t WS_MIX = 304 * MiB;
constexpr size_t WS_RSQ = 368 * MiB;
constexpr size_t WS_REC = 370 * MiB;
constexpr size_t WS_END = 512 * MiB;
constexpr size_t OUT_AP1 = 0, OUT_AP2 = 24 * MiB, OUT_ADEN = 48 * MiB, OUT_GT7 = 51 * MiB;
constexpr int OFF_P1T = 0, OFF_RT = 2048, OFF_BK = 4096  , OFF_VT = 8192, OFF_MM = 10240  , OFF_W2 = 11264, OFF_GAM = 11776, OFF_RK = 12032, RECB = 12096, GTB = 2048, SLOTB = 14336;
constexpr int NSC = SEQ / 16;
constexpr size_t OUT_YF = 54 * MiB;
static_assert(OUT_GT7 + 3 * MiB <= OUT_YF && OUT_YF + (size_t)BATCH * NH * NSC * 2048 <= (size_t)M * DM * 4, "scratch inside d_out");
static_assert(W_END <= WS_XB && WS_XB + (size_t)M * DM * 2 <= WS_PH && WS_PH + (size_t)M * PP * 2 <= WS_MIX && WS_MIX + (size_t)M * DM * 2 <= WS_RSQ && WS_RSQ + (size_t)M * 16 * 4 <= WS_REC && WS_REC + (size_t)BATCH * NH * NSC * RECB <= WS_END && WS_W + 7 * 3 * MiB <= W_OUT, "d_ws map");
constexpr int CW_BAR = 4096;

constexpr int RING_OFF = 0, RING_BYTES = 131072;
constexpr int LDSCTL_OFF = RING_BYTES, MISC_OFF = LDSCTL_OFF + 320;
constexpr int LDS_BYTES = 147456;

#define GAS __attribute__((address_space(1)))
#define LAS __attribute__((address_space(3)))
#define DI __device__ __forceinline__
typedef unsigned short bf16;
typedef unsigned v4u __attribute__((ext_vector_type(4)));
typedef unsigned v2u __attribute__((ext_vector_type(2)));
typedef float f32x4 __attribute__((ext_vector_type(4)));
typedef float f32x2 __attribute__((ext_vector_type(2)));
typedef short bf16x8 __attribute__((ext_vector_type(8)));
typedef short v4i16_t __attribute__((ext_vector_type(4)));
typedef GAS unsigned gu32;
#define RLX_AGENT __ATOMIC_RELAXED, __HIP_MEMORY_SCOPE_AGENT
#define LDS_WAIT() asm volatile("s_waitcnt lgkmcnt(0)" ::: "memory")
DI unsigned f2bf(float f) { unsigned u = __builtin_bit_cast(unsigned, f); return (u + 0x7fffu + ((u >> 16) & 1u)) >> 16; }
typedef float f32x2_t __attribute__((ext_vector_type(2))); typedef __bf16 bf16x2_t __attribute__((ext_vector_type(2)));
DI unsigned pk2(float lo, float hi) { f32x2_t v = {lo, hi}; bf16x2_t b = __builtin_convertvector(v, bf16x2_t); return __builtin_bit_cast(unsigned, b); }
DI float bflo(unsigned w) { return __builtin_bit_cast(float, w << 16); }
DI float bfhi(unsigned w) { return __builtin_bit_cast(float, w & 0xffff0000u); }
DI float bf1(bf16 h) { return __builtin_bit_cast(float, (unsigned)h << 16); }
DI void unpack8(const v4u w, float (&f)[8]) { f[0] = bflo(w.x); f[1] = bfhi(w.x); f[2] = bflo(w.y); f[3] = bfhi(w.y); f[4] = bflo(w.z); f[5] = bfhi(w.z); f[6] = bflo(w.w); f[7] = bfhi(w.w); }
DI v4u pack8(const float (&f)[8]) { v4u w; w.x = pk2(f[0], f[1]); w.y = pk2(f[2], f[3]); w.z = pk2(f[4], f[5]); w.w = pk2(f[6], f[7]); return w; }
DI void unpack4(const v2u w, float (&f)[4]) { f[0] = bflo(w.x); f[1] = bfhi(w.x); f[2] = bflo(w.y); f[3] = bfhi(w.y); }
DI float sigmoid_f(float x) { return __builtin_amdgcn_rcpf(1.0f + __expf(-x)); }
DI float silu_x(float x) { return x * sigmoid_f(x); }
DI float tanh_f(float x) { const float e = __expf(-2.0f * fabsf(x)); const float t = (1.0f - e) * __builtin_amdgcn_rcpf(1.0f + e); return x < 0.f ? -t : t; }

DI f32x4 mfma16k(v4i16_t a, v4i16_t b, f32x4 c, int, int, int) {
    const bf16x8 a8 = (bf16x8){a[0], a[1], a[2], a[3], 0, 0, 0, 0}, b8 = (bf16x8){b[0], b[1], b[2], b[3], 0, 0, 0, 0};
    return __builtin_amdgcn_mfma_f32_16x16x32_bf16(a8, b8, c, 0, 0, 0);
}
#define XB_TMO      128
#define XB_XCNT(j)  (256  + 64 * (j))
#define XB_XSUB(j)  (1280 + 64 * (j))
#define XB_XGEN(j)  (2304 + 64 * (j))
#define XB_TOP      3328
#define XB_TOPGEN   3392
#define XCD_BAR_WORDS 3456
#define XB_SPIN_CAP (1u << 18)

__device__ __forceinline__ unsigned xb_ld(unsigned* p)              { return __hip_atomic_load(p, __ATOMIC_RELAXED, __HIP_MEMORY_SCOPE_AGENT); }
__device__ __forceinline__ unsigned xb_add(unsigned* p, unsigned v) { return __hip_atomic_fetch_add(p, v, __ATOMIC_RELAXED, __HIP_MEMORY_SCOPE_AGENT); }
__device__ __forceinline__ unsigned xb_xcc_id() { return (unsigned)__builtin_amdgcn_s_getreg((3 << 11) | 20) & 0xFu; }
#define XB_SPIN(cond, bar) do { unsigned _sp = 0; while (cond) { __builtin_amdgcn_s_sleep(1); \
    if ((++_sp & 255u) == 0u) { if (xb_ld(&(bar)[XB_TMO])) break; if (_sp > XB_SPIN_CAP) { atomicAdd(&(bar)[XB_TMO], 1u); break; } } } } while (0)

struct XcdBarrier {
    unsigned* bar; unsigned x;
    volatile LAS unsigned* st;
};

__device__ __forceinline__ XcdBarrier xcd_barrier_post(unsigned* bar, volatile LAS unsigned* st) {
    XcdBarrier b; b.bar = bar; b.x = xb_xcc_id(); b.st = st;
    if (threadIdx.x == 0) (void)xb_add(&bar[XB_XCNT(b.x)], 1u);
    return b;
}
__device__ __forceinline__ void xcd_barrier_complete(unsigned* bar, unsigned x, unsigned& nloc, unsigned& nx) {
    const unsigned G = gridDim.x * gridDim.y * gridDim.z;
    unsigned sum, cnt, mine, sp = 0u;
    for (;;) {
        sum = 0u; cnt = 0u; mine = 0u;
#pragma unroll
        for (unsigned j = 0; j < 16; ++j) { const unsigned c = xb_ld(&bar[XB_XCNT(j)]); sum += c; cnt += (c > 0u) ? 1u : 0u; mine = (j == x) ? c : mine; }
        if (sum == G) break;
        __builtin_amdgcn_s_sleep(1);
        if ((++sp & 255u) == 0u) { if (xb_ld(&bar[XB_TMO])) break; if (sp > XB_SPIN_CAP) { atomicAdd(&bar[XB_TMO], 1u); break; } }
    }
    nloc = mine > 0u ? mine : 1u; nx = cnt > 0u ? cnt : 1u;
}

__device__ __forceinline__ void xcd_barrier(const XcdBarrier& b) {
    asm volatile("s_waitcnt vmcnt(0)" ::: "memory");
    __syncthreads();
    if (threadIdx.x == 0) {
        unsigned* bar = b.bar;
        __builtin_amdgcn_s_waitcnt(0);
        unsigned nloc = b.st[0], nx = b.st[1];
        if (nloc == 0u) { xcd_barrier_complete(bar, b.x, nloc, nx); b.st[0] = nloc; b.st[1] = nx; }
        const unsigned old = xb_add(&bar[XB_XSUB(b.x)], 1u);
        const unsigned gen = old / nloc;
        if (old + 1u == (gen + 1u) * nloc) {
            __builtin_amdgcn_fence(__ATOMIC_RELEASE, "agent");
            asm volatile("s_waitcnt vmcnt(0)" ::: "memory");
            const unsigned og = xb_add(&bar[XB_TOP], 1u);
            const unsigned tg = og / nx;
            if (og + 1u == (tg + 1u) * nx) xb_add(&bar[XB_TOPGEN], 1u);
            else XB_SPIN(xb_ld(&bar[XB_TOPGEN]) == tg, bar);
            __builtin_amdgcn_fence(__ATOMIC_ACQUIRE, "agent");
            xb_add(&bar[XB_XGEN(b.x)], 1u);
            asm volatile("s_waitcnt vmcnt(0)" ::: "memory");
        } else {
            XB_SPIN(xb_ld(&bar[XB_XGEN(b.x)]) == gen, bar);
            __builtin_amdgcn_fence(__ATOMIC_ACQUIRE, "agent");
            asm volatile("s_waitcnt vmcnt(0)" ::: "memory");
        }
    }
    __syncthreads();
}

struct Args { const float* in[N_IN]; float* out; unsigned char* ws; int l_lo, l_hi, ph_lo, ph_hi, single, pad; };
struct Frame {
    LAS unsigned char* lds;
    volatile LAS unsigned* MISC;
    gu32* ctl;
    int tid, lane, wave, G, bid;
};
DI float wave_sum(float v) {
#pragma unroll
    for (int o = 1; o < 64; o <<= 1) v += __shfl_xor(v, o);
    return v;
}
DI float wave_max(float v) {
#pragma unroll
    for (int o = 1; o < 64; o <<= 1) v = fmaxf(v, __shfl_xor(v, o));
    return v;
}
DI float row16_sum(float v) {
    v += __builtin_bit_cast(float, __builtin_amdgcn_mov_dpp(__builtin_bit_cast(int, v), 0xB1, 0xF, 0xF, true));
    v += __builtin_bit_cast(float, __builtin_amdgcn_mov_dpp(__builtin_bit_cast(int, v), 0x4E, 0xF, 0xF, true));
    v += __builtin_bit_cast(float, __builtin_amdgcn_mov_dpp(__builtin_bit_cast(int, v), 0x141, 0xF, 0xF, true));
    v += __builtin_bit_cast(float, __builtin_amdgcn_mov_dpp(__builtin_bit_cast(int, v), 0x140, 0xF, 0xF, true));
    return v;
}

DI void tr_item(const float* W, int K, int N, const float* ksc, float cs, bf16* WT, int drow0, LAS float* scr, int kb, int nb, int lane) {
    const int k0 = 64 * kb, n0 = 32 * nb;
    f32x4 v[8]; float sc[8];
#pragma unroll
    for (int i = 0; i < 8; ++i) { const int kk = 8 * i + (lane >> 3); v[i] = *(const GAS f32x4*)(W + (size_t)(k0 + kk) * N + n0 + 4 * (lane & 7)); sc[i] = ksc ? ksc[k0 + kk] * cs : cs; }
#pragma unroll
    for (int i = 0; i < 8; ++i) { const int kk = 8 * i + (lane >> 3); LAS float* d = scr + kk * 33 + 4 * (lane & 7); d[0] = v[i][0] * sc[i]; d[1] = v[i][1] * sc[i]; d[2] = v[i][2] * sc[i]; d[3] = v[i][3] * sc[i]; }
    LDS_WAIT(); asm volatile("" ::: "memory");
    const int c = lane & 7;
#pragma unroll
    for (int j = 0; j < 4; ++j) { const int n = (lane >> 3) + 8 * j; const LAS float* s = scr + (8 * c) * 33 + n;
        v4u o; o.x = pk2(s[0 * 33], s[1 * 33]); o.y = pk2(s[2 * 33], s[3 * 33]); o.z = pk2(s[4 * 33], s[5 * 33]); o.w = pk2(s[6 * 33], s[7 * 33]);
        *(GAS v4u*)(WT + (size_t)(drow0 + n) * K + k0 + 8 * c) = o; }
    LDS_WAIT(); asm volatile("" ::: "memory");
}
DI int glu_row(int nb, int up) { const int n0 = 32 * nb; return (n0 >> 7) * 256 + (n0 & 127) + up * 128; }
DI void phase0(const Frame& F, const Args& a, int l) {
    LAS float* scr = (LAS float*)(F.lds + RING_OFF + F.wave * 16384);
    const int gw = F.bid * NWAVES + F.wave, NGW = F.G * NWAVES;
    unsigned char* ws = a.ws;
    const float* nf1 = a.in[I_NF1] + (size_t)l * DM; const float* nmx = a.in[I_NMIX] + (size_t)l * DM; const float* nf2 = a.in[I_NF2] + (size_t)l * DM;
    const float* wg1 = a.in[I_WG1] + (size_t)l * DM * FF; const float* wu1 = a.in[I_WU1] + (size_t)l * DM * FF; const float* wd1 = a.in[I_WD1] + (size_t)l * FF * DM;
    const float* wg2 = a.in[I_WG2] + (size_t)l * DM * FF; const float* wu2 = a.in[I_WU2] + (size_t)l * DM * FF; const float* wd2 = a.in[I_WD2] + (size_t)l * FF * DM;
    const float* win = a.in[I_WIN] + (size_t)l * DM * DIN; const float* wout = a.in[I_WOUT] + (size_t)l * DM * DM;
    constexpr int I_GU = 16 * 88, I_DN = 44 * 32, I_IN = 16 * 92, I_OUT = 16 * 32, NITEMS = 4 * I_GU + 2 * I_DN + I_IN + I_OUT;
    for (int it = gw; it < NITEMS; it += NGW) {
        int r = it;
        if (r < I_GU) { tr_item(wg1, DM, FF, nf1, 1.f, (bf16*)(ws + W_UP1), glu_row(r % 88, 0), scr, r / 88, r % 88, F.lane); continue; } r -= I_GU;
        if (r < I_GU) { tr_item(wu1, DM, FF, nf1, 1.f, (bf16*)(ws + W_UP1), glu_row(r % 88, 1), scr, r / 88, r % 88, F.lane); continue; } r -= I_GU;
        if (r < I_DN) { tr_item(wd1, FF, DM, nullptr, 0.5f, (bf16*)(ws + W_DN1), 32 * (r % 32), scr, r / 32, r % 32, F.lane); continue; } r -= I_DN;
        if (r < I_IN) { tr_item(win, DM, DIN, nmx, 1.f, (bf16*)(ws + W_IN), 32 * (r % 92), scr, r / 92, r % 92, F.lane); continue; } r -= I_IN;
        if (r < I_OUT) { tr_item(wout, DM, DM, nullptr, 1.f, (bf16*)(ws + W_OUT), 32 * (r % 32), scr, r / 32, r % 32, F.lane); continue; } r -= I_OUT;
        if (r < I_GU) { tr_item(wg2, DM, FF, nf2, 1.f, (bf16*)(ws + W_UP2), glu_row(r % 88, 0), scr, r / 88, r % 88, F.lane); continue; } r -= I_GU;
        if (r < I_GU) { tr_item(wu2, DM, FF, nf2, 1.f, (bf16*)(ws + W_UP2), glu_row(r % 88, 1), scr, r / 88, r % 88, F.lane); continue; } r -= I_GU;
        tr_item(wd2, FF, DM, nullptr, 0.5f, (bf16*)(ws + W_DN2), 32 * (r % 32), scr, r / 32, r % 32, F.lane);
    }
    const int gt = F.bid * (NWAVES * 64) + F.tid, NGT = F.G * NWAVES * 64;
    for (int i = gt; i < (PP - DIN) * DM * 2 / 16; i += NGT) ((GAS v4u*)(ws + W_IN + (size_t)DIN * DM * 2))[i] = (v4u){0u, 0u, 0u, 0u};
    const float* w2 = a.in[I_W2] + (size_t)l * 32 * DR; const float* a2 = a.in[I_A2] + (size_t)l * 32 * DR; const float* g2 = a.in[I_G2] + (size_t)l * 64 * DR;
    bf16* lf = (bf16*)(ws + WS_LORA);
    for (int i = gt; i < 6144; i += NGT) {
        const float* src; int nt, ks, ln;
        if (i < 1536) { src = w2; nt = i >> 6; ks = 0; ln = i & 63; }
        else if (i < 3072) { src = a2; nt = (i - 1536) >> 6; ks = 0; ln = i & 63; }
        else { src = g2; const int ii = i - 3072; nt = ii >> 7; ks = (ii >> 6) & 1; ln = ii & 63; }
        const int n = ln & 15, q = ln >> 4; float f[8];
#pragma unroll
        for (int j = 0; j < 8; ++j) f[j] = src[(size_t)(32 * ks + 8 * q + j) * DR + 16 * nt + n];
        *(GAS v4u*)(lf + (size_t)i * 8) = pack8(f);
    }
    if (l == 0) {
        const float* x = a.in[I_X]; bf16* xb = (bf16*)(ws + WS_XB); float* rsq = (float*)(ws + WS_RSQ);
        for (int row = gw; row < M; row += NGW) {
            const GAS f32x4* xr = (const GAS f32x4*)(x + (size_t)row * DM) + F.lane; float ss = 0.f;
            GAS v2u* o8 = (GAS v2u*)(xb + (size_t)row * DM) + F.lane;
#pragma unroll
            for (int j = 0; j < 4; ++j) { const f32x4 v = xr[64 * j]; ss += (v[0] * v[0] + v[1] * v[1]) + (v[2] * v[2] + v[3] * v[3]); v2u w; w.x = pk2(v[0], v[1]); w.y = pk2(v[2], v[3]); o8[64 * j] = w; }
            ss = wave_sum(ss);
            if (F.lane < 16) rsq[(size_t)row * 16 + F.lane] = (F.lane == 0) ? ss : 0.f;
        }
    }
}

DI void shift8(const bf16* pr, bool has_prev, int col, const LAS float* mu, float (&o)[8]) {
    const v4u c = *(const GAS v4u*)(pr + col); v4u p = *(const GAS v4u*)(pr - (has_prev ? PP : 0) + col);
    if (!has_prev) p = (v4u){0u, 0u, 0u, 0u};
    float fc[8], fp[8]; unpack8(c, fc); unpack8(p, fp);
    const f32x4 m0 = *(const LAS f32x4*)(mu + col), m1 = *(const LAS f32x4*)(mu + col + 4);
#pragma unroll
    for (int j = 0; j < 8; ++j) { const float m = j < 4 ? m0[j] : m1[j - 4]; o[j] = fc[j] + (fp[j] - fc[j]) * m; }
}
DI void shift4(const bf16* pr, bool has_prev, int col, const LAS float* mu, float (&o)[4]) {
    const v2u c = *(const GAS v2u*)(pr + col); v2u p = *(const GAS v2u*)(pr - (has_prev ? PP : 0) + col);
    if (!has_prev) p = (v2u){0u, 0u};
    float fc[4], fp[4]; unpack4(c, fc); unpack4(p, fp);
    const f32x4 m0 = *(const LAS f32x4*)(mu + col);
#pragma unroll
    for (int j = 0; j < 4; ++j) o[j] = fc[j] + (fp[j] - fc[j]) * m0[j];
}
DI void shift4r(const v2u c, v2u p, bool has_prev, int col, const LAS float* mu, float (&o)[4]) {
    if (!has_prev) p = (v2u){0u, 0u};
    float fc[4], fp[4]; unpack4(c, fc); unpack4(p, fp);
    const f32x4 m0 = *(const LAS f32x4*)(mu + col);
#pragma unroll
    for (int j = 0; j < 4; ++j) o[j] = fc[j] + (fp[j] - fc[j]) * m0[j];
}
DI unsigned char* rec_ptr(unsigned char* ws, int b, int h, int sc) { return ws + WS_REC + (size_t)((b * NH + h) * NSC + sc) * RECB; }
DI unsigned char* gt_ptr(unsigned char* ws, unsigned char* outscr, int b, int h, int sc) { return (b < 7 ? ws + WS_W + (size_t)b * 3 * MiB : outscr + OUT_GT7) + (size_t)(h * NSC + sc) * GTB; }

#define ROW_SHR_ADD(x, n) x += __builtin_bit_cast(float, __builtin_amdgcn_update_dpp(0, __builtin_bit_cast(int, x), 0x110 + (n), 0xf, 0xf, true))
DI float row_prefix16(float x) { ROW_SHR_ADD(x, 1); ROW_SHR_ADD(x, 2); ROW_SHR_ADD(x, 4); ROW_SHR_ADD(x, 8); return x; }
DI v4i16_t pk4(float a, float b, float c, float d) { v2u w; w.x = pk2(a, b); w.y = pk2(c, d); return __builtin_bit_cast(v4i16_t, w); }
DI v4i16_t tr_read4(const LAS unsigned char* p) { return __builtin_amdgcn_ds_read_tr16_b64_v4i16((LAS v4i16_t*)p); }
constexpr int PL_PARAM = RING_OFF + 8 * 14336  ;
constexpr int PL_AT = 0, PL_BT = 2304, PL_KT = 4608, PL_V = 6912, PL_G = 9216, PL_MAB = 11520, PL_MKA = 12544, PL_BYTES = 14336, PL_PITCH = 144;
DI void prepass_unit(const Frame& F, const Args& a, int l, int wu) {
    const int lane = F.lane, tok = lane & 15, quad = lane >> 4, row = wu * 16 + tok; const bool has_prev = (row & (SEQ - 1)) != 0;
    const int b = (wu * 16) / SEQ, sc = ((wu * 16) & (SEQ - 1)) >> 4;
    unsigned char* ws = a.ws;
    LAS unsigned char* L = F.lds + RING_OFF + F.wave * PL_BYTES;
    const bf16* pr = (const bf16*)(ws + WS_PH) + (size_t)row * PP;
    const LAS float* mu = (const LAS float*)(F.lds + PL_PARAM); const LAS float* w0 = mu + DSHIFT; const LAS float* a0 = w0 + DR; const LAS float* kk_ = a0 + DR; const LAS float* ka_ = kk_ + DR; const LAS float* rk_ = ka_ + DR;
    const bf16* lf = (const bf16*)(ws + WS_LORA);
    bf16x8 fw, fa, fg0, fg1;
    { float t[8]; shift8(pr, has_prev, C_XW + 8 * quad, mu, t);
#pragma unroll
      for (int j = 0; j < 8; ++j) t[j] = tanh_f(t[j]);
      fw = __builtin_bit_cast(bf16x8, pack8(t));
      shift8(pr, has_prev, C_XA + 8 * quad, mu, t); fa = __builtin_bit_cast(bf16x8, pack8(t));
      shift8(pr, has_prev, C_XG + 8 * quad, mu, t);
#pragma unroll
      for (int j = 0; j < 8; ++j) t[j] = sigmoid_f(t[j]);
      fg0 = __builtin_bit_cast(bf16x8, pack8(t));
      shift8(pr, has_prev, C_XG + 32 + 8 * quad, mu, t);
#pragma unroll
      for (int j = 0; j < 8; ++j) t[j] = sigmoid_f(t[j]);
      fg1 = __builtin_bit_cast(bf16x8, pack8(t)); }
    const f32x4 z4 = (f32x4){0.f, 0.f, 0.f, 0.f};
#pragma unroll 1
    for (int hi_ = 0; hi_ < NH; ++hi_) {
        int hh = hi_; asm volatile("" : "+s"(hh));
        unsigned char* rec = rec_ptr(ws, b, hh, sc); unsigned char* gtp = gt_ptr(ws, (unsigned char*)a.out, b, hh, sc);
        float ss = 0.f, rkp = 0.f; float ksv[4][4];
        const bf16* prq = pr - (has_prev ? PP : 0);
        v2u kc[4], kq[4], er[2][2], ev[2][2];
#pragma unroll
        for (int q4 = 0; q4 < 4; ++q4) { const int c = 16 * (4 * hh + q4) + 4 * quad; kc[q4] = *(const GAS v2u*)(pr + C_K + c); kq[q4] = *(const GAS v2u*)(prq + C_K + c); }
#pragma unroll
        for (int q4 = 0; q4 < 2; ++q4) { const int c = 16 * (4 * hh + q4) + 4 * quad;
            er[q4][0] = *(const GAS v2u*)(pr + C_R + c); er[q4][1] = *(const GAS v2u*)(prq + C_R + c); ev[q4][0] = *(const GAS v2u*)(pr + C_V + c); ev[q4][1] = *(const GAS v2u*)(prq + C_V + c); }
#pragma unroll
        for (int q4 = 0; q4 < 4; ++q4) { const int c = 16 * (4 * hh + q4) + 4 * quad; const f32x4 kk4 = *(const LAS f32x4*)(kk_ + c); shift4r(kc[q4], kq[q4], has_prev, C_K + c, mu, ksv[q4]);
#pragma unroll
            for (int j = 0; j < 4; ++j) { const float kr = ksv[q4][j] * kk4[j]; ss += kr * kr; } }
        ss += __shfl_xor(ss, 16); ss += __shfl_xor(ss, 32);
        const float inv = __builtin_amdgcn_rsqf(ss + 1e-12f);
        v4u At2[2], Bt2[2], Kt2[2], Rt2[2];
#pragma unroll
        for (int q4 = 0; q4 < 4; ++q4) {
            const int nt = 4 * hh + q4, c = 16 * nt + 4 * quad;
            const bf16x8 wf = *(const GAS bf16x8*)(lf + (size_t)(nt * 64 + lane) * 8), af = *(const GAS bf16x8*)(lf + (size_t)(1536 + nt * 64 + lane) * 8);
            const bf16x8 gf0 = *(const GAS bf16x8*)(lf + (size_t)(3072 + (nt * 2 + 0) * 64 + lane) * 8), gf1 = *(const GAS bf16x8*)(lf + (size_t)(3072 + (nt * 2 + 1) * 64 + lane) * 8);
            const f32x4 Dw = __builtin_amdgcn_mfma_f32_16x16x32_bf16(wf, fw, z4, 0, 0, 0);
            const f32x4 Da = __builtin_amdgcn_mfma_f32_16x16x32_bf16(af, fa, z4, 0, 0, 0);
            f32x4 Dg = __builtin_amdgcn_mfma_f32_16x16x32_bf16(gf0, fg0, z4, 0, 0, 0);
            Dg = __builtin_amdgcn_mfma_f32_16x16x32_bf16(gf1, fg1, Dg, 0, 0, 0);
            const f32x4 w04 = *(const LAS f32x4*)(w0 + c), a04 = *(const LAS f32x4*)(a0 + c), kk4 = *(const LAS f32x4*)(kk_ + c), ka4 = *(const LAS f32x4*)(ka_ + c), rk4 = *(const LAS f32x4*)(rk_ + c);
            float rsh[4], vs[4]; const float (&ks)[4] = ksv[q4];
            if (q4 < 2) { shift4r(er[q4 & 1][0], er[q4 & 1][1], has_prev, C_R + c, mu, rsh); shift4r(ev[q4 & 1][0], ev[q4 & 1][1], has_prev, C_V + c, mu, vs); }
            else { shift4(pr, has_prev, C_R + c, mu, rsh); shift4(pr, has_prev, C_V + c, mu, vs); }
            const int lo = tok * PL_PITCH + (16 * q4 + 4 * quad) * 2;
            *(LAS v4i16_t*)(L + PL_V + lo) = pk4(vs[0], vs[1], vs[2], vs[3]);
            *(LAS v4i16_t*)(L + PL_G + lo) = pk4(Dg[0], Dg[1], Dg[2], Dg[3]);
            float at[4], bt[4], kt[4], rt[4], gm[4];
#pragma unroll
            for (int j = 0; j < 4; ++j) { const float e = 0.60653066f * sigmoid_f(w04[j] + Dw[j]), agj = sigmoid_f(a04[j] + Da[j]), cum = row_prefix16(e);
                const float G = __expf(-cum), Gp = __expf(e - cum), Gi = __expf(cum), kkn = ks[j] * kk4[j] * inv, kpj = ks[j] * (1.0f + (agj - 1.0f) * ka4[j]);
                rkp += rsh[j] * kpj * rk4[j];
                at[j] = -kkn * Gp; bt[j] = kkn * agj * Gi; kt[j] = kpj * Gi; rt[j] = rsh[j] * G; gm[j] = G; }
            const unsigned a01 = pk2(at[0], at[1]), a23 = pk2(at[2], at[3]), b01 = pk2(bt[0], bt[1]), b23 = pk2(bt[2], bt[3]), k01 = pk2(kt[0], kt[1]), k23 = pk2(kt[2], kt[3]), r01 = pk2(rt[0], rt[1]), r23 = pk2(rt[2], rt[3]);
            if (q4 & 1) { At2[q4 >> 1].z = a01; At2[q4 >> 1].w = a23; Bt2[q4 >> 1].z = b01; Bt2[q4 >> 1].w = b23; Kt2[q4 >> 1].z = k01; Kt2[q4 >> 1].w = k23; Rt2[q4 >> 1].z = r01; Rt2[q4 >> 1].w = r23; }
            else { At2[q4 >> 1].x = a01; At2[q4 >> 1].y = a23; Bt2[q4 >> 1].x = b01; Bt2[q4 >> 1].y = b23; Kt2[q4 >> 1].x = k01; Kt2[q4 >> 1].y = k23; Rt2[q4 >> 1].x = r01; Rt2[q4 >> 1].y = r23; }
            *(LAS v2u*)(L + PL_AT + lo) = (v2u){a01, a23}; *(LAS v2u*)(L + PL_BT + lo) = (v2u){b01, b23}; *(LAS v2u*)(L + PL_KT + lo) = (v2u){k01, k23};
            if (tok == 15) *(GAS f32x4*)(rec + OFF_GAM + (16 * q4 + 4 * quad) * 4) = (f32x4){gm[0], gm[1], gm[2], gm[3]};
            if (q4 & 1) asm volatile("" ::: "memory");
        }
        rkp += __shfl_xor(rkp, 16); rkp += __shfl_xor(rkp, 32);
        f32x4 Mab = __builtin_amdgcn_mfma_f32_16x16x32_bf16(__builtin_bit_cast(bf16x8, Bt2[0]), __builtin_bit_cast(bf16x8, At2[0]), z4, 0, 0, 0);
        Mab = __builtin_amdgcn_mfma_f32_16x16x32_bf16(__builtin_bit_cast(bf16x8, Bt2[1]), __builtin_bit_cast(bf16x8, At2[1]), Mab, 0, 0, 0);
        f32x4 Mka = __builtin_amdgcn_mfma_f32_16x16x32_bf16(__builtin_bit_cast(bf16x8, Kt2[0]), __builtin_bit_cast(bf16x8, At2[0]), z4, 0, 0, 0);
        Mka = __builtin_amdgcn_mfma_f32_16x16x32_bf16(__builtin_bit_cast(bf16x8, Kt2[1]), __builtin_bit_cast(bf16x8, At2[1]), Mka, 0, 0, 0);
        f32x4 Mbr = __builtin_amdgcn_mfma_f32_16x16x32_bf16(__builtin_bit_cast(bf16x8, Bt2[0]), __builtin_bit_cast(bf16x8, Rt2[0]), z4, 0, 0, 0);
        Mbr = __builtin_amdgcn_mfma_f32_16x16x32_bf16(__builtin_bit_cast(bf16x8, Bt2[1]), __builtin_bit_cast(bf16x8, Rt2[1]), Mbr, 0, 0, 0);
        f32x4 Mkr = __builtin_amdgcn_mfma_f32_16x16x32_bf16(__builtin_bit_cast(bf16x8, Kt2[0]), __builtin_bit_cast(bf16x8, Rt2[0]), z4, 0, 0, 0);
        Mkr = __builtin_amdgcn_mfma_f32_16x16x32_bf16(__builtin_bit_cast(bf16x8, Kt2[1]), __builtin_bit_cast(bf16x8, Rt2[1]), Mkr, 0, 0, 0);
#pragma unroll
        for (int j = 0; j < 4; ++j) { const int s = 4 * quad + j; if (!(s < tok)) { Mab[j] = 0.f; Mka[j] = 0.f; } if (!(s <= tok)) { Mbr[j] = 0.f; Mkr[j] = 0.f; }
            *(LAS float*)(L + PL_MAB + (s * 16 + tok) * 4) = Mab[j]; *(LAS float*)(L + PL_MKA + (s * 16 + tok) * 4) = Mka[j]; }
        { v4u mm; mm.x = pk2(Mbr[0], Mbr[1]); mm.y = pk2(Mbr[2], Mbr[3]); mm.z = pk2(Mkr[0], Mkr[1]); mm.w = pk2(Mkr[2], Mkr[3]); *(GAS v4u*)(rec + OFF_MM + lane * 16) = mm; }
        *(GAS v4u*)(rec + OFF_RT + lane * 16) = Rt2[0]; *(GAS v4u*)(rec + OFF_RT + (64 + lane) * 16) = Rt2[1];
        if (quad == 0) *(GAS float*)(rec + OFF_RK + tok * 4) = rkp;
        LDS_WAIT(); asm volatile("" ::: "memory");
        float Tc[16]; f32x4 mrow[2][4];
        Tc[15] = (tok == 15) ? 1.0f : 0.0f;
        mrow[0][3] = *(const LAS f32x4*)(L + PL_MAB + (14 * 16 + 12) * 4);
        asm volatile("" ::: "memory");
#pragma unroll
        for (int s = 14; s >= 0; --s) { float acc = (s == tok) ? 1.0f : 0.0f;
            if (s > 0) {
#pragma unroll
                for (int q = s >> 2; q < 4; ++q) mrow[(s + 1) & 1][q] = *(const LAS f32x4*)(L + PL_MAB + ((s - 1) * 16 + 4 * q) * 4);
            }
            asm volatile("" ::: "memory");
#pragma unroll
            for (int q = (s + 1) >> 2; q < 4; ++q) { const f32x4 m = mrow[s & 1][q];
#pragma unroll
                for (int j = 0; j < 4; ++j) if (4 * q + j > s) acc += m[j] * Tc[4 * q + j]; }
            Tc[s] = acc; }
        float tf[4];
#pragma unroll
        for (int j = 0; j < 4; ++j) tf[j] = (quad == 0) ? Tc[j] : (quad == 1) ? Tc[4 + j] : (quad == 2) ? Tc[8 + j] : Tc[12 + j];
        const v4i16_t Tf = pk4(tf[0], tf[1], tf[2], tf[3]);
        const int tro = (4 * quad + (tok >> 2)) * PL_PITCH + 8 * (tok & 3);
        v4u P1[2];
#pragma unroll
        for (int jt = 0; jt < 4; ++jt) {
            const v4i16_t Af = tr_read4(L + PL_AT + tro + 32 * jt);
            const f32x4 D = mfma16k(Af, Tf, z4, 0, 0, 0);
            const unsigned p01 = pk2(D[0], D[1]), p23 = pk2(D[2], D[3]);
            if (jt & 1) { P1[jt >> 1].z = p01; P1[jt >> 1].w = p23; } else { P1[jt >> 1].x = p01; P1[jt >> 1].y = p23; }
            { const v4i16_t bt = tr_read4(L + PL_BT + tro + 32 * jt), kt = tr_read4(L + PL_KT + tro + 32 * jt);
              *(GAS bf16x8*)(rec + OFF_BK + (jt * 64 + lane) * 16) = (bf16x8){bt[0], bt[1], bt[2], bt[3], kt[0], kt[1], kt[2], kt[3]}; }
            *(GAS v4i16_t*)(rec + OFF_VT + (jt * 64 + lane) * 8) = tr_read4(L + PL_V + tro + 32 * jt);
            *(GAS v4i16_t*)(gtp + (jt * 64 + lane) * 8) = tr_read4(L + PL_G + tro + 32 * jt);
        }
        *(GAS v4u*)(rec + OFF_P1T + lane * 16) = P1[0]; *(GAS v4u*)(rec + OFF_P1T + (64 + lane) * 16) = P1[1];
        { const f32x4 mk = *(const LAS f32x4*)(L + PL_MKA + (tok * 16 + 4 * quad) * 4);
          const f32x4 W2 = mfma16k(pk4(mk[0], mk[1], mk[2], mk[3]), Tf, z4, 0, 0, 0);
          *(GAS v4i16_t*)(rec + OFF_W2 + lane * 8) = pk4(W2[0], W2[1], W2[2], W2[3]); }
        LDS_WAIT(); asm volatile("" ::: "memory");
    }
}
constexpr int CV_T = 32, CV_ROWS = CV_T + CW - 1;
DI void conv_unit(const Frame& F, const Args& a, int l, int cu) {
    const int b = cu / (SEQ / CV_T), t0 = (cu % (SEQ / CV_T)) * CV_T;
    unsigned char* ws = a.ws;
    const bf16* proj = (const bf16*)(ws + WS_PH); bf16* mix = (bf16*)(ws + WS_MIX);
    LAS float* z = (LAS float*)(F.lds + RING_OFF);
    LAS float* ob = z + CV_ROWS * DC;
    const LAS float* cw = ob + CV_T * DC; const LAS float* cb = cw + CW * DC;
    const float* lw = a.in[I_CLW] + (size_t)l * DC; const float* lb = a.in[I_CLB] + (size_t)l * DC;
    { const int c8 = (F.tid & 31) * 8;
      for (int r = F.tid >> 5; r < CV_ROWS; r += 16) { const int t = t0 - (CW - 1) + r; float zz[8];
          if (t >= 0) { const bf16* pr = proj + (size_t)(b * SEQ + t) * PP; float u[8], g[8]; unpack8(*(const GAS v4u*)(pr + C_CU + c8), u); unpack8(*(const GAS v4u*)(pr + C_CG + c8), g);
#pragma unroll
              for (int j = 0; j < 8; ++j) zz[j] = u[j] * sigmoid_f(g[j]); }
          else {
#pragma unroll
              for (int j = 0; j < 8; ++j) zz[j] = 0.f; }
          *(LAS f32x4*)(z + r * DC + c8) = (f32x4){zz[0], zz[1], zz[2], zz[3]}; *(LAS f32x4*)(z + r * DC + c8 + 4) = (f32x4){zz[4], zz[5], zz[6], zz[7]}; } }
    __syncthreads();
    { const int ch = F.tid & 255, half = F.tid >> 8; float w[CW];
#pragma unroll
      for (int j = 0; j < CW; ++j) w[j] = cw[j * DC + ch];
      const float bias = cb[ch];
#pragma unroll 2
      for (int tt = 0; tt < 16; ++tt) { const int tl = 16 * half + tt; float acc = bias;
#pragma unroll
          for (int j = 0; j < CW; ++j) acc += z[(tl + j) * DC + ch] * w[j];
          ob[tl * DC + ch] = acc; } }
    __syncthreads();
#pragma unroll 1
    for (int i = 0; i < CV_T / NWAVES; ++i) { const int tl = F.wave * (CV_T / NWAVES) + i; const f32x4 v = *(const LAS f32x4*)(ob + tl * DC + 4 * F.lane);
        const float mean = wave_sum((v[0] + v[1]) + (v[2] + v[3])) * (1.0f / DC); const f32x4 d = v - mean;
        const float var = wave_sum((d[0] * d[0] + d[1] * d[1]) + (d[2] * d[2] + d[3] * d[3])) * (1.0f / DC); const float rstd = __builtin_amdgcn_rsqf(var + 1e-5f);
        const f32x4 lw4 = *(const GAS f32x4*)(lw + 4 * F.lane), lb4 = *(const GAS f32x4*)(lb + 4 * F.lane); float o[4];
#pragma unroll
        for (int j = 0; j < 4; ++j) { const float y = d[j] * rstd * lw4[j] + lb4[j]; o[j] = silu_x(y); }
        v2u w2; w2.x = pk2(o[0], o[1]); w2.y = pk2(o[2], o[3]);
        *(GAS v2u*)(mix + (size_t)(b * SEQ + t0 + tl) * DM + 768 + 4 * F.lane) = w2; }
    __syncthreads();
}
DI void conv_stage_taps(const Frame& F, const Args& a, int l) {
    LAS float* cw = (LAS float*)(F.lds + RING_OFF) + (CV_ROWS + CV_T) * DC;
    for (int i = F.tid; i < (CW + 1) * DC; i += NWAVES * 64) cw[i] = (i < CW * DC) ? a.in[I_CW][(size_t)l * CW * DC + i] : a.in[I_CB][(size_t)l * DC + i - CW * DC];
    __syncthreads();
}
DI void phase4(const Frame& F, const Args& a, int l) {
    const int gw = F.bid * NWAVES + F.wave, NGW = F.G * NWAVES;
#ifndef PREP_REP
#define PREP_REP 1
#endif
#ifndef CONV_REP
#define CONV_REP 1
#endif
    { LAS float* pt = (LAS float*)(F.lds + PL_PARAM);
      for (int i = F.tid; i < DSHIFT + 5 * DR; i += NWAVES * 64) { const int j = i - DSHIFT, k = j / DR, c = j - k * DR;
          pt[i] = (i < DSHIFT) ? a.in[I_MU][(size_t)l * DSHIFT + i] : a.in[(k == 0) ? I_W0 : (k == 1) ? I_A0 : (k == 2) ? I_KK : (k == 3) ? I_KA : I_RK][(size_t)l * DR + c]; }
      __syncthreads(); }
    for (int wu = gw; wu < PREP_REP * (M / 16); wu += NGW) prepass_unit(F, a, l, wu % (M / 16));
    __syncthreads();
}

DI void ld8f(const float* p, float (&o)[8]) { const f32x4 a = *(const GAS f32x4*)p, b = *(const GAS f32x4*)(p + 4); o[0] = a[0]; o[1] = a[1]; o[2] = a[2]; o[3] = a[3]; o[4] = b[0]; o[5] = b[1]; o[6] = b[2]; o[7] = b[3]; }
constexpr int SC_NB = 4, SC_PIECES = (RECB + GTB) / 16, SC_REC_PIECES = RECB / 16;
#define SC_BARRIER() asm volatile("s_waitcnt lgkmcnt(0)\n\ts_barrier" ::: "memory")
struct ScanFrags { bf16x8 P0, P1, R0, R1, MM; v4i16_t Vf, W2; };
DI void scan_frags(ScanFrags& f, const LAS unsigned char* slot, int rg, int lane) {
    f.P0 = *(const LAS bf16x8*)(slot + OFF_P1T + lane * 16); f.P1 = *(const LAS bf16x8*)(slot + OFF_P1T + (64 + lane) * 16);
    f.R0 = *(const LAS bf16x8*)(slot + OFF_RT + lane * 16); f.R1 = *(const LAS bf16x8*)(slot + OFF_RT + (64 + lane) * 16);
    f.Vf = *(const LAS v4i16_t*)(slot + OFF_VT + (rg * 64 + lane) * 8);
    f.MM = *(const LAS bf16x8*)(slot + OFF_MM + lane * 16); f.W2 = *(const LAS v4i16_t*)(slot + OFF_W2 + lane * 8);
}
DI void scan_bh(const Frame& F, const Args& a, int l, int bh) {
    const int b = bh / NH, h = bh % NH, lane = F.lane, il = lane & 15, quad = lane >> 4, rg = F.wave & 3;
    unsigned char* ws = a.ws;
    LAS unsigned char* ring = F.lds + RING_OFF;
    const bool is_scan = F.wave < 4;
    const unsigned char* rec0 = rec_ptr(ws, b, h, 0);
    const int ltid = rg * 64 + lane;
    constexpr int NB2 = 8, SL2 = 12288, SCP = OFF_RK / 16;
    v4u lr[12];
#define SC_LOAD2(scx, o_) do { _Pragma("unroll") for (int i_ = 0; i_ < 3; ++i_) { const int p_ = ltid + 256 * i_; if (p_ < SCP) lr[(o_) + i_] = *(const GAS v4u*)(rec0 + (size_t)(scx) * RECB + p_ * 16); } } while (0)
#define SC_STORE2(scx, o_) do { _Pragma("unroll") for (int i_ = 0; i_ < 3; ++i_) { const int p_ = ltid + 256 * i_; if (p_ < SCP) *(LAS v4u*)(ring + ((scx) & (NB2 - 1)) * SL2 + p_ * 16) = lr[(o_) + i_]; } } while (0)
    if (!is_scan) { SC_LOAD2(0, 0); SC_LOAD2(1, 3); SC_LOAD2(2, 6); SC_LOAD2(3, 9); SC_STORE2(0, 0); SC_STORE2(1, 3); SC_STORE2(2, 6); SC_STORE2(3, 9); SC_LOAD2(4, 0); SC_LOAD2(5, 3); SC_LOAD2(6, 6); SC_LOAD2(7, 9); }
    SC_BARRIER();
    f32x4 S[4];
#pragma unroll
    for (int jt = 0; jt < 4; ++jt) S[jt] = (f32x4){0.f, 0.f, 0.f, 0.f};
    unsigned char* yfp = (unsigned char*)a.out + OUT_YF + ((size_t)(b * NH + h) * NSC * 4 + rg) * 512 + lane * 8;
    const f32x4 z4 = (f32x4){0.f, 0.f, 0.f, 0.f};
    ScanFrags fn;
#pragma unroll 1
    for (int it = 0; it < NSC / 4; ++it) {
        if (is_scan) {
#pragma unroll
            for (int s2 = 0; s2 < 4; ++s2) {
                const int sc = 4 * it + s2;
                const LAS unsigned char* slot = ring + (sc & (NB2 - 1)) * SL2;
                if (s2 == 0) scan_frags(fn, slot, rg, lane);
                const ScanFrags f = fn;
                if (s2 < 3) scan_frags(fn, ring + ((sc + 1) & (NB2 - 1)) * SL2, rg, lane);
                v4u sb0, sb1;
                sb0.x = pk2(S[0][0], S[0][1]); sb0.y = pk2(S[0][2], S[0][3]); sb0.z = pk2(S[1][0], S[1][1]); sb0.w = pk2(S[1][2], S[1][3]);
                sb1.x = pk2(S[2][0], S[2][1]); sb1.y = pk2(S[2][2], S[2][3]); sb1.z = pk2(S[3][0], S[3][1]); sb1.w = pk2(S[3][2], S[3][3]);
                const bf16x8 Sb0 = __builtin_bit_cast(bf16x8, sb0), Sb1 = __builtin_bit_cast(bf16x8, sb1);
                f32x4 U = mfma16k(f.W2, f.Vf, z4, 0, 0, 0);
                U = __builtin_amdgcn_mfma_f32_16x16x32_bf16(f.P0, Sb0, U, 0, 0, 0);
                U = __builtin_amdgcn_mfma_f32_16x16x32_bf16(f.P1, Sb1, U, 0, 0, 0);
                f32x4 Y = __builtin_amdgcn_mfma_f32_16x16x32_bf16(f.R0, Sb0, z4, 0, 0, 0);
                Y = __builtin_amdgcn_mfma_f32_16x16x32_bf16(f.R1, Sb1, Y, 0, 0, 0);
                const v4i16_t Ub = pk4(U[0], U[1], U[2], U[3]);
                const bf16x8 UV = (bf16x8){Ub[0], Ub[1], Ub[2], Ub[3], f.Vf[0], f.Vf[1], f.Vf[2], f.Vf[3]};
#pragma unroll
                for (int jt = 0; jt < 4; ++jt) {
                    const bf16x8 BK = *(const LAS bf16x8*)(slot + OFF_BK + (jt * 64 + lane) * 16);
                    const f32x4 gm = *(const LAS f32x4*)(slot + OFF_GAM + (16 * jt + 4 * quad) * 4);
                    S[jt] = __builtin_amdgcn_mfma_f32_16x16x32_bf16(BK, UV, S[jt], 0, 0, 0);
                    S[jt] = S[jt] * gm;
                }
                Y = __builtin_amdgcn_mfma_f32_16x16x32_bf16(f.MM, UV, Y, 0, 0, 0);
                { v2u yw; yw.x = pk2(Y[0], Y[1]); yw.y = pk2(Y[2], Y[3]); *(GAS v2u*)(yfp + (size_t)sc * 2048) = yw; }
            }
        } else {
            if (4 * it + 4 < NSC) { SC_STORE2(4 * it + 4, 0); SC_STORE2(4 * it + 5, 3); SC_STORE2(4 * it + 6, 6); SC_STORE2(4 * it + 7, 9); }
            if (4 * it + 8 < NSC) { SC_LOAD2(4 * it + 8, 0); SC_LOAD2(4 * it + 9, 3); SC_LOAD2(4 * it + 10, 6); SC_LOAD2(4 * it + 11, 9); }
        }
        SC_BARRIER();
    }
    SC_BARRIER();
#undef SC_LOAD2
#undef SC_STORE2
}

constexpr int AT_PITCH = 144, AT_KEYS = 384, AT_K = 0, AT_V = AT_KEYS * AT_PITCH, AT_PASSES = AT_KEYS / 64, AT_UPB = 48  ;
constexpr int AT_GAIN = LDSCTL_OFF + 2048;
#define ATT_DPP_ADD(x, ctrl) x += __builtin_bit_cast(float, __builtin_amdgcn_update_dpp(0, __builtin_bit_cast(int, x), ctrl, 0xf, 0xf, true))
DI v4i16_t tr_read(const LAS unsigned char* p) { return __builtin_amdgcn_ds_read_tr16_b64_v4i16((LAS v4i16_t*)p); }
struct AttnDecode { int b, h, d, c, n; };
DI AttnDecode attn_decode(int un) {
    AttnDecode u; const int bh = un / AT_UPB, iu = un % AT_UPB, p = iu >> 4, r = iu & 15; u.b = bh / NH; u.h = bh % NH;
    u.d = (p == 0) ? 1 : (p == 1) ? 4 : 16; u.c = (p == 0) ? 0 : (p == 1) ? (r >> 2) : r; u.n = (p == 0) ? r : (p == 1) ? (r & 3) : 0; return u;
}
struct AttnRegs { v4u k[AT_PASSES], v[AT_PASSES], q0[2], q1[2]; };
DI void attn_issue(const Frame& F, const Args& a, int un, AttnRegs& R) {
    const AttnDecode u = attn_decode(un); const bf16* proj = (const bf16*)(a.ws + WS_PH);
    const int r8 = F.tid >> 3, ch = F.tid & 7;
#pragma unroll
    for (int pass = 0; pass < AT_PASSES; ++pass) { int uk = 256 * u.n - 128 + pass * 64 + r8; uk = uk < 0 ? 0 : uk;
        const bf16* src = proj + ((size_t)u.b * SEQ + u.c + u.d * uk) * PP + 64 * u.h + 8 * ch;
        R.k[pass] = *(const GAS v4u*)(src + C_AK); R.v[pass] = *(const GAS v4u*)(src + C_AV); }
    const int qi = F.lane & 15, quad = F.lane >> 4;
#pragma unroll
    for (int tq = 0; tq < 2; ++tq) { const int uq = 256 * u.n + 32 * F.wave + 16 * tq + qi;
        const bf16* qsrc = proj + ((size_t)u.b * SEQ + u.c + u.d * uq) * PP + C_Q + 64 * u.h;
        R.q0[tq] = *(const GAS v4u*)(qsrc + 8 * quad); R.q1[tq] = *(const GAS v4u*)(qsrc + 32 + 8 * quad); }
}
DI void attn_unit(const Frame& F, const Args& a, int l, int un, float shift2, AttnRegs& R, int un_next) {
    const AttnDecode u = attn_decode(un); const int b = u.b, h = u.h, d = u.d, c = u.c, n = u.n, p = (d == 1) ? 0 : (d == 4) ? 1 : 2;
    unsigned char* ws = a.ws;
    const LAS float* gq = (const LAS float*)(F.lds + AT_GAIN); const LAS float* gk = gq + HD;
    const float slope = (h == 0) ? 0.25f : (h == 1) ? 0.0625f : (h == 2) ? 0.015625f : (h == 3) ? 0.00390625f : (h == 4) ? 0.5f : 0.125f;
    const float bco = -slope * (float)d * LOG2E;
    const int kb_lo = (n == 0) ? 128 : 0;
    LAS unsigned char* lds = F.lds + RING_OFF;
    {   const int r8 = F.tid >> 3, ch = F.tid & 7;
        const f32x4 g0 = *(const LAS f32x4*)(gk + 8 * ch), g1 = *(const LAS f32x4*)(gk + 8 * ch + 4);
#pragma unroll
        for (int pass = 0; pass < AT_PASSES; ++pass) {
            const int kb = pass * 64 + r8;
            float kf[8]; unpack8(R.k[pass], kf); float ss = 0.f;
#pragma unroll
            for (int j = 0; j < 8; ++j) ss += kf[j] * kf[j];
            ATT_DPP_ADD(ss, 0xB1); ATT_DPP_ADD(ss, 0x4E); ATT_DPP_ADD(ss, 0x141);
            const float sc = __builtin_amdgcn_rsqf(ss * (1.0f / HD) + 1e-6f);
#pragma unroll
            for (int j = 0; j < 8; ++j) kf[j] *= sc * (j < 4 ? g0[j] : g1[j - 4]);
            *(LAS v4u*)(lds + AT_K + kb * AT_PITCH + ch * 16) = pack8(kf);
            *(LAS v4u*)(lds + AT_V + kb * AT_PITCH + ch * 16) = R.v[pass];
        }
    }
    const int w = F.wave, qi = F.lane & 15, quad = F.lane >> 4;
    bf16x8 Qf0[2], Qf1[2];
    {   const f32x4 a0 = *(const LAS f32x4*)(gq + 8 * quad), a1 = *(const LAS f32x4*)(gq + 8 * quad + 4), b0 = *(const LAS f32x4*)(gq + 32 + 8 * quad), b1 = *(const LAS f32x4*)(gq + 32 + 8 * quad + 4);
#pragma unroll
        for (int tq = 0; tq < 2; ++tq) {
            float f0[8], f1[8]; unpack8(R.q0[tq], f0); unpack8(R.q1[tq], f1);
            float ss = 0.f;
#pragma unroll
            for (int j = 0; j < 8; ++j) ss += f0[j] * f0[j] + f1[j] * f1[j];
            ss += __shfl_xor(ss, 16); ss += __shfl_xor(ss, 32);
            const float sc = __builtin_amdgcn_rsqf(ss * (1.0f / HD) + 1e-6f) * (0.125f * LOG2E);
#pragma unroll
            for (int j = 0; j < 8; ++j) { f0[j] *= sc * (j < 4 ? a0[j] : a1[j - 4]); f1[j] *= sc * (j < 4 ? b0[j] : b1[j - 4]); }
            Qf0[tq] = __builtin_bit_cast(bf16x8, pack8(f0)); Qf1[tq] = __builtin_bit_cast(bf16x8, pack8(f1)); } }
    __syncthreads();
    if (un_next >= 0) attn_issue(F, a, un_next, R);
    f32x4 O[2][4];
#pragma unroll
    for (int tq = 0; tq < 2; ++tq)
#pragma unroll
        for (int dt = 0; dt < 4; ++dt) O[tq][dt] = (f32x4){0.f, 0.f, 0.f, 0.f};
    float lsum[2] = {0.f, 0.f};
    int g_lo = w; if (g_lo < (kb_lo >> 5)) g_lo = kb_lo >> 5;
    const int g_hi = w + 4, qpos0 = 128 + 32 * w + qi;
    float Bj[4]; int dq[4];
#pragma unroll
    for (int j = 0; j < 4; ++j) { dq[j] = qpos0 - 4 * quad - j; Bj[j] = bco * (float)dq[j] - shift2; }
    const float bt16 = bco * 16.0f;
    const f32x4 z4a = (f32x4){0.f, 0.f, 0.f, 0.f};
#pragma unroll 1
    for (int g = g_lo; g <= g_hi; ++g) {
        float pk[2][8];
        const bool interior = (g >= w + 1) && (g <= w + 3);
#pragma unroll
        for (int hf = 0; hf < 2; ++hf) {
            const int kb0 = 32 * g + 16 * hf; const float cgh = bco * (float)kb0;
            const LAS unsigned char* kaddr = lds + AT_K + (kb0 + qi) * AT_PITCH + quad * 16;
            const bf16x8 kf0 = *(const LAS bf16x8*)(kaddr), kf1 = *(const LAS bf16x8*)(kaddr + 64);
#pragma unroll
            for (int tq = 0; tq < 2; ++tq) {
                if ((tq == 0 && hf == 1 && g == w + 4) || (tq == 1 && hf == 0 && g == w)) {
#pragma unroll
                    for (int j = 0; j < 4; ++j) pk[tq][4 * hf + j] = 0.f;
                    continue; }
                f32x4 Sx = __builtin_amdgcn_mfma_f32_16x16x32_bf16(kf0, Qf0[tq], z4a, 0, 0, 0);
                Sx = __builtin_amdgcn_mfma_f32_16x16x32_bf16(kf1, Qf1[tq], Sx, 0, 0, 0);
                const float toff = tq ? bt16 : 0.f;
                if (interior) {
#pragma unroll
                    for (int j = 0; j < 4; ++j) { const float pv = __builtin_amdgcn_exp2f(Sx[j] + ((Bj[j] + toff) - cgh)); lsum[tq] += pv; pk[tq][4 * hf + j] = pv; }
                } else {
#pragma unroll
                    for (int j = 0; j < 4; ++j) { const int dist = dq[j] + 16 * tq - kb0;
                        const float pv = (dist >= 0 && dist <= 128) ? __builtin_amdgcn_exp2f(Sx[j] + ((Bj[j] + toff) - cgh)) : 0.f;
                        lsum[tq] += pv; pk[tq][4 * hf + j] = pv; }
                }
            }
        }
        const bf16x8 Pf0 = __builtin_bit_cast(bf16x8, pack8(pk[0])), Pf1 = __builtin_bit_cast(bf16x8, pack8(pk[1]));
        const LAS unsigned char* vaddr = lds + AT_V + (32 * g + 4 * quad + (qi >> 2)) * AT_PITCH + 8 * (qi & 3);
#pragma unroll
        for (int dt = 0; dt < 4; ++dt) {
            const v4i16_t lo = tr_read(vaddr + 32 * dt), hi = tr_read(vaddr + 32 * dt + 16 * AT_PITCH);
            const bf16x8 Vf = (bf16x8){lo[0], lo[1], lo[2], lo[3], hi[0], hi[1], hi[2], hi[3]};
            O[0][dt] = __builtin_amdgcn_mfma_f32_16x16x32_bf16(Vf, Pf0, O[0][dt], 0, 0, 0);
            O[1][dt] = __builtin_amdgcn_mfma_f32_16x16x32_bf16(Vf, Pf1, O[1][dt], 0, 0, 0);
        }
    }
#pragma unroll
    for (int tq = 0; tq < 2; ++tq) {
        float ls = lsum[tq]; ls += __shfl_xor(ls, 16); ls += __shfl_xor(ls, 32);
        const int uq = 256 * n + 32 * w + 16 * tq + qi; const size_t qrow = (size_t)b * SEQ + c + d * uq;
        bf16* dst = (p == 0) ? (bf16*)(ws + WS_MIX) + qrow * DM + DR + 64 * h : (p == 1) ? (bf16*)((unsigned char*)a.out + OUT_AP1) + qrow * DR + 64 * h : (bf16*)((unsigned char*)a.out + OUT_AP2) + qrow * DR + 64 * h;
#pragma unroll
        for (int dt = 0; dt < 4; ++dt) { v2u wv; wv.x = pk2(O[tq][dt][0], O[tq][dt][1]); wv.y = pk2(O[tq][dt][2], O[tq][dt][3]); *(GAS v2u*)(dst + 16 * dt + 4 * quad) = wv; }
        if (quad == 0) ((float*)((unsigned char*)a.out + OUT_ADEN))[((size_t)p * M + qrow) * 8 + h] = ls;
    }
    __syncthreads();
}
constexpr int N_SCAN_ITEMS = BATCH * NH, N_ATT_UNITS = BATCH * NH * AT_UPB;
#ifndef SCAN_REP
#define SCAN_REP 1
#endif
#ifndef ATT_REP
#define ATT_REP 1
#endif
#ifndef ATT_SCAN
#define ATT_SCAN 1
#endif
DI void phase5(const Frame& F, const Args& a, int l) {
    const int nsb = (F.G >= 2 * N_SCAN_ITEMS) ? N_SCAN_ITEMS : 0;
    if (F.bid < nsb) { for (int rep = 0; rep < SCAN_REP; ++rep) scan_bh(F, a, l, F.bid); }
    else if (nsb == 0) { for (int it = F.bid; it < N_SCAN_ITEMS; it += F.G) scan_bh(F, a, l, it); }
    const float gqv = a.in[I_QN][(size_t)l * HD + F.lane], gkv = a.in[I_KN][(size_t)l * HD + F.lane];
    const float gqm = wave_max(fabsf(gqv)), gkm = wave_max(fabsf(gkv));
    if (F.wave == 0) { ((LAS float*)(F.lds + AT_GAIN))[F.lane] = gqv; ((LAS float*)(F.lds + AT_GAIN))[HD + F.lane] = gkv; }
    __syncthreads();
    const float shift2 = 8.0f * gqm * gkm * LOG2E;
    int u0, u1;
    if (F.bid < nsb) { u0 = F.bid * ATT_SCAN; u1 = u0 + ATT_SCAN; }
    else { const int base = nsb * ATT_SCAN, nrest = N_ATT_UNITS - base, aw = F.bid - nsb, naw = F.G - nsb, per = nrest / naw, rem = nrest % naw;
        u0 = base + aw * per + (aw < rem ? aw : rem); u1 = u0 + per + (aw < rem ? 1 : 0); }
    for (int rep = 0; rep < ATT_REP; ++rep) { AttnRegs R;
        if (u0 < u1) attn_issue(F, a, u0, R);
        for (int un = u0; un < u1; ++un) attn_unit(F, a, l, un, shift2, R, (un + 1 < u1) ? un + 1 : -1); }
    if (F.bid >= nsb) { const int aw = F.bid - nsb, naw = F.G - nsb; conv_stage_taps(F, a, l);
        const int ncu = BATCH * (SEQ / CV_T), cper = ncu / naw, crem = ncu % naw, c0 = aw * cper + (aw < crem ? aw : crem), c1 = c0 + cper + (aw < crem ? 1 : 0);
        for (int cu = c0; cu < c1; ++cu) conv_unit(F, a, l, cu); }
}

struct PostRegs { v2u yv[4], vv[4], gv[4]; f32x4 rk; float lnw[4], lnb[4]; };
DI void rwkv_post_issue(const Frame& F, const Args& a, int l, int un, PostRegs& R) {
    const int bh = un / NSC, sc = un % NSC, b = bh / NH, h = bh % NH, quad = F.lane >> 4, il = F.lane & 15;
    unsigned char* ws = a.ws;
    const unsigned char* rec = rec_ptr(ws, b, h, sc); const unsigned char* gtp = gt_ptr(ws, (unsigned char*)a.out, b, h, sc);
    const unsigned char* yfp = (const unsigned char*)a.out + OUT_YF + ((size_t)(b * NH + h) * NSC + sc) * 2048 + F.lane * 8;
    R.rk = *(const GAS f32x4*)(rec + OFF_RK + 16 * quad);
#pragma unroll
    for (int r = 0; r < 4; ++r) { R.lnw[r] = a.in[I_LNW][(size_t)l * DR + 64 * h + 16 * r + il]; R.lnb[r] = a.in[I_LNB][(size_t)l * DR + 64 * h + 16 * r + il]; }
#pragma unroll
    for (int r = 0; r < 4; ++r) { R.yv[r] = *(const GAS v2u*)(yfp + r * 512); R.vv[r] = *(const GAS v2u*)(rec + OFF_VT + (r * 64 + F.lane) * 8); R.gv[r] = *(const GAS v2u*)(gtp + (r * 64 + F.lane) * 8); }
}
DI void rwkv_post_finish(const Frame& F, const Args& a, int l, int un, const PostRegs& R) {
    const int bh = un / NSC, sc = un % NSC, b = bh / NH, h = bh % NH, il = F.lane & 15, quad = F.lane >> 4;
    bf16* mixp = (bf16*)(a.ws + WS_MIX) + ((size_t)b * SEQ + 16 * sc + 4 * quad) * DM + 64 * h + il;
    float y[4][4], v[4][4], g[4][4];
#pragma unroll
    for (int r = 0; r < 4; ++r) { unpack4(R.yv[r], y[r]); unpack4(R.vv[r], v[r]); unpack4(R.gv[r], g[r]); }
#pragma unroll
    for (int e = 0; e < 4; ++e) {
        float s1 = 0.f, s2 = 0.f;
#pragma unroll
        for (int r = 0; r < 4; ++r) { s1 += y[r][e]; s2 += y[r][e] * y[r][e]; }
        s1 = row16_sum(s1); s2 = row16_sum(s2);
        const float mean = s1 * (1.0f / HD), var = s2 * (1.0f / HD) - mean * mean, rstd = __builtin_amdgcn_rsqf(fmaxf(var, 0.f) + 64e-5f);
#pragma unroll
        for (int r = 0; r < 4; ++r) { const float o = ((y[r][e] - mean) * rstd * R.lnw[r] + R.lnb[r] + R.rk[e] * v[r][e]) * g[r][e];
            *(GAS bf16*)(mixp + (size_t)e * DM + 16 * r) = (bf16)(pk2(o, 0.f) & 0xffffu); }
    }
}
DI void phase6(const Frame& F, const Args& a, int l) {
    const int gw = F.bid * NWAVES + F.wave, NGW = F.G * NWAVES;
    { PostRegs R0, R1;
      int un = gw; const int NU = BATCH * NH * NSC;
      if (un < NU) rwkv_post_issue(F, a, l, un, R0);
#pragma unroll 1
      for (; un < NU; un += 2 * NGW) {
          if (un + NGW < NU) rwkv_post_issue(F, a, l, un + NGW, R1);
          rwkv_post_finish(F, a, l, un, R0);
          if (un + NGW < NU) { if (un + 2 * NGW < NU) rwkv_post_issue(F, a, l, un + 2 * NGW, R0); rwkv_post_finish(F, a, l, un + NGW, R1); }
      } }
    const int ln = F.lane < 48 ? F.lane : F.lane - 16; const bool act = F.lane < 48;
    const int c0 = 8 * ln, hh = ln >> 3; unsigned char* ws = a.ws;
    bf16* mix = (bf16*)(ws + WS_MIX);
    const unsigned char* oscr = (const unsigned char*)a.out; const bf16* P1 = (const bf16*)(oscr + OUT_AP1); const bf16* P2 = (const bf16*)(oscr + OUT_AP2); const float* DEN = (const float*)(oscr + OUT_ADEN);
#pragma unroll 1
    for (int row0 = gw; row0 < M; row0 += 8 * NGW) {
        v4u n0[8], n1[8], n2[8]; float den[8];
#pragma unroll
        for (int k = 0; k < 8; ++k) { int row = row0 + k * NGW; row = row < M ? row : row0;
            n0[k] = *(const GAS v4u*)(mix + (size_t)row * DM + DR + c0); n1[k] = *(const GAS v4u*)(P1 + (size_t)row * DR + c0); n2[k] = *(const GAS v4u*)(P2 + (size_t)row * DR + c0);
            den[k] = DEN[(size_t)row * 8 + hh] + DEN[((size_t)M + row) * 8 + hh] + DEN[((size_t)2 * M + row) * 8 + hh]; }
#pragma unroll
        for (int k = 0; k < 8; ++k) { const int row = row0 + k * NGW; float f0[8], f1[8], f2[8], o[8]; unpack8(n0[k], f0); unpack8(n1[k], f1); unpack8(n2[k], f2);
            const float rd = 1.0f / den[k];
#pragma unroll
            for (int j = 0; j < 8; ++j) o[j] = (f0[j] + f1[j] + f2[j]) * rd;
            if (act && row < M) *(GAS v4u*)(mix + (size_t)row * DM + DR + c0) = pack8(o); }
    }
}

#ifndef MK_SINGLE
#define MK_SINGLE 1
#endif
__global__ void __launch_bounds__(NWAVES * 64, 2) mk_fwd(Args args) {
    extern __shared__ __attribute__((aligned(16))) unsigned char lds[];
    Frame F;
    F.lds = (LAS unsigned char*)lds;
    F.MISC = (volatile LAS unsigned*)(F.lds + MISC_OFF);
    F.tid = threadIdx.x; F.lane = F.tid & 63; F.wave = __builtin_amdgcn_readfirstlane(F.tid >> 6);
    F.G = gridDim.x; F.bid = blockIdx.x;
    unsigned char* ws = args.ws;
    F.ctl = (gu32*)(ws + WS_CTL);
    for (int u = F.tid; u < (LDS_BYTES - LDSCTL_OFF) / 4; u += NWAVES * 64) ((LAS unsigned*)(F.lds + LDSCTL_OFF))[u] = 0u;
    __syncthreads();
    XcdBarrier bar; bar.bar = (unsigned*)(F.ctl + CW_BAR); bar.x = 0; bar.st = nullptr;
    if (args.single) bar = xcd_barrier_post((unsigned*)(F.ctl + CW_BAR), F.MISC + 8);
#define GRID_BAR() do { if (args.single) xcd_barrier(bar); } while (0)
    const int lo = args.ph_lo, hi = args.ph_hi;
#ifndef PH_MASK
#define PH_MASK 0x3ff
#endif
#define IN(k) (((PH_MASK >> (k)) & 1) && lo <= (k) && (k) < hi)
#ifndef DUP_MASK
#define DUP_MASK 0
#endif
#define REP(k) for (int rep_ = 0; rep_ < (((DUP_MASK >> (k)) & 1) ? 2 : 1); ++rep_)
    const pg8::bf16_t* XB = (const pg8::bf16_t*)(ws + WS_XB); pg8::bf16_t* PH = (pg8::bf16_t*)(ws + WS_PH); pg8::bf16_t* MIXB = (pg8::bf16_t*)(ws + WS_MIX); float* RSQ = (float*)(ws + WS_RSQ);
#pragma unroll 1
    for (int l = args.l_lo; l < args.l_hi; ++l) {
        { int t_ = threadIdx.x; asm volatile("" : "+v"(t_)); F.tid = t_; F.lane = t_ & 63; F.wave = __builtin_amdgcn_readfirstlane(t_ >> 6); }
        if (IN(0)) REP(0) { phase0(F, args, l); GRID_BAR(); }
        if (IN(1)) REP(1) {
            pg8::Gemm g{XB, (const pg8::bf16_t*)(ws + W_UP1), M, NUP, DM}; pg8::StaticOrder S; S.init(M, NUP, F.G, F.bid);
            pg8::EpiSwiglu E{PH, FF, RSQ, (LAS float*)(F.lds + LDSCTL_OFF + 1024)};
            pg8::gemm_phase<pg8::EpiSwiglu, pg8::StaticOrder, true, true>(F.lds + RING_OFF, g, S, E);
            GRID_BAR(); }
        if (IN(2)) REP(2) {
            pg8::Gemm g{PH, (const pg8::bf16_t*)(ws + W_DN1), M, DM, FF}; pg8::StaticOrder S; S.init(M, DM, F.G, F.bid);
            pg8::EpiResidual E{nullptr, (pg8::bf16_t*)(ws + WS_XB), RSQ, DM};
            pg8::gemm_phase<pg8::EpiResidual, pg8::StaticOrder, true, true>(F.lds + RING_OFF, g, S, E);
            GRID_BAR(); }
        if (IN(3)) REP(3) {
            pg8::Gemm g{XB, (const pg8::bf16_t*)(ws + W_IN), M, PP, DM}; pg8::StaticOrder S; S.init(M, PP, F.G, F.bid);
            pg8::EpiProj E{PH, PP, RSQ, (LAS float*)(F.lds + LDSCTL_OFF + 1024)};
            pg8::gemm_phase<pg8::EpiProj, pg8::StaticOrder, true, true>(F.lds + RING_OFF, g, S, E);
            GRID_BAR(); }
        if (IN(4)) REP(4) { phase4(F, args, l); GRID_BAR(); }
        if (IN(5)) REP(5) { phase5(F, args, l); GRID_BAR(); }
        if (IN(6)) REP(6) { phase6(F, args, l); GRID_BAR(); }
        if (IN(7)) REP(7) {
            pg8::Gemm g{MIXB, (const pg8::bf16_t*)(ws + W_OUT), M, DM, DM}; pg8::StaticOrder S; S.init(M, DM, F.G, F.bid);
            pg8::EpiResidual E{nullptr, (pg8::bf16_t*)(ws + WS_XB), RSQ, DM};
            pg8::gemm_phase<pg8::EpiResidual, pg8::StaticOrder, true, true>(F.lds + RING_OFF, g, S, E);
            GRID_BAR(); }
        if (IN(8)) REP(8) {
            pg8::Gemm g{XB, (const pg8::bf16_t*)(ws + W_UP2), M, NUP, DM}; pg8::StaticOrder S; S.init(M, NUP, F.G, F.bid);
            pg8::EpiSwiglu E{PH, FF, RSQ, (LAS float*)(F.lds + LDSCTL_OFF + 1024)};
            pg8::gemm_phase<pg8::EpiSwiglu, pg8::StaticOrder, true, true>(F.lds + RING_OFF, g, S, E);
            GRID_BAR(); }
        if (IN(9)) REP(9) {
            pg8::Gemm g{PH, (const pg8::bf16_t*)(ws + W_DN2), M, DM, FF}; pg8::StaticOrder S; S.init(M, DM, F.G, F.bid);
            pg8::EpiResidual E{(l == DEPTH - 1) ? args.out : nullptr, (pg8::bf16_t*)(ws + WS_XB), RSQ, DM};
            pg8::gemm_phase<pg8::EpiResidual, pg8::StaticOrder, true, true>(F.lds + RING_OFF, g, S, E);
            GRID_BAR(); }
    }
#undef IN
#undef GRID_BAR
}

extern "C" void kernel_launch(void* const* d_in, const int* in_sizes, int n_in, void* d_out, int out_size, void* d_ws, size_t ws_size, hipStream_t stream) {
    static int grid = 0;
    if (grid == 0) {
        if (n_in != N_IN || in_sizes[0] != M * DM || out_size != M * DM || ws_size < WS_END) { fprintf(stderr, "kernel_launch: unexpected shapes (n_in %d, in0 %d, out %d, ws %zu < %zu); nothing launched\n", n_in, n_in > 0 ? in_sizes[0] : -1, out_size, ws_size, (size_t)WS_END); grid = -1; return; }
        int dev = 0, cus = 0, per_cu = 0;
        if (hipGetDevice(&dev) != hipSuccess || hipDeviceGetAttribute(&cus, hipDeviceAttributeMultiprocessorCount, dev) != hipSuccess) { grid = -1; return; }
        if (hipFuncSetAttribute((const void*)mk_fwd, hipFuncAttributeMaxDynamicSharedMemorySize, LDS_BYTES) != hipSuccess) { fprintf(stderr, "kernel_launch: hipFuncSetAttribute failed\n"); grid = -1; return; }
        if (hipOccupancyMaxActiveBlocksPerMultiprocessor(&per_cu, (const void*)mk_fwd, NWAVES * 64, LDS_BYTES) != hipSuccess || per_cu < 1) fprintf(stderr, "kernel_launch: occupancy query reports %d\n", per_cu);
        (void)hipGetLastError();
        grid = cus;
    }
    if (grid < 0) return;
    if (hipMemsetAsync((char*)d_ws + WS_CTL, 0, CTL_ZERO_BYTES, stream) != hipSuccess) return;
    Args a{};
    for (int i = 0; i < N_IN; ++i) a.in[i] = (const float*)d_in[i];
    a.out = (float*)d_out; a.ws = (unsigned char*)d_ws; a.pad = 0;
#if MK_SINGLE
    a.l_lo = 0; a.l_hi = DEPTH; a.ph_lo = 0; a.ph_hi = NPH; a.single = 1;
    hipLaunchKernelGGL(mk_fwd, dim3(grid), dim3(NWAVES * 64), LDS_BYTES, stream, a);
#else
    for (int l = 0; l < DEPTH; ++l)
        for (int ph = 0; ph < NPH; ++ph) { a.l_lo = l; a.l_hi = l + 1; a.ph_lo = ph; a.ph_hi = ph + 1; a.single = 0;
            hipLaunchKernelGGL(mk_fwd, dim3(grid), dim3(NWAVES * 64), LDS_BYTES, stream, a); }
#endif
}
```
